# Optimizing an MI355X kernel written in HIP

```python
import math
import jax, jax.numpy as jnp
from jax import lax
import numpy as np

D_MODEL = 1024
BATCH = 4
SEQ = 8192
DEPTH = 4

HEAD_DIM = 64
N_HEADS = D_MODEL // HEAD_DIM
H_FOX = N_HEADS // 4
H_DSA = N_HEADS // 4
H_DIL = N_HEADS // 4
H_MOBA = N_HEADS - H_FOX - H_DSA - H_DIL
IDX_HEADS = 8
IDX_DIM = 32
DSA_TOPK = 256
DIL_PATTERNS = ((128, 1), (512, 4), (2048, 16))
MOBA_BLOCK = 256
MOBA_TOPK = 3
Q_BLOCK = 128
MOBA_Q_BLOCK = 64
D_FF = 4 * D_MODEL
ROPE_THETA = 10000.0
LN_EPS = 1e-5
DEEPNORM_ALPHA = (2.0 * DEPTH) ** 0.25
DEEPNORM_BETA = (8.0 * DEPTH) ** -0.25
ATTN_SCALE = HEAD_DIM ** -0.5

SPLIT_SIZES = (
    H_FOX * HEAD_DIM, H_FOX * HEAD_DIM, H_FOX * HEAD_DIM, H_FOX,
    H_DSA * HEAD_DIM, H_DSA * HEAD_DIM, H_DSA * HEAD_DIM,
    IDX_HEADS * IDX_DIM, IDX_DIM, IDX_HEADS,
    H_DIL * HEAD_DIM, H_DIL * HEAD_DIM, H_DIL * HEAD_DIM,
    H_MOBA * HEAD_DIM, H_MOBA * HEAD_DIM, H_MOBA * HEAD_DIM,
)
D_IN = sum(SPLIT_SIZES)

kernel_name = "hymba_style_fox_dsa_dilated_moba_trunk"

F32 = jnp.float32


def layer_norm(x, g, b):
    xf = x.astype(F32)
    mu = jnp.mean(xf, axis=-1, keepdims=True)
    var = jnp.mean(jnp.square(xf - mu), axis=-1, keepdims=True)
    return ((xf - mu) * lax.rsqrt(var + LN_EPS) * g.astype(F32) + b.astype(F32)).astype(x.dtype)


def rope(x, pos):
    d = x.shape[-1]
    half = d // 2
    inv = ROPE_THETA ** (-jnp.arange(half, dtype=F32) / half)
    ang = pos.astype(F32)[:, None] * inv[None, :]
    cos = jnp.cos(ang)[None, :, None, :]
    sin = jnp.sin(ang)[None, :, None, :]
    xf = x.astype(F32)
    x1, x2 = xf[..., :half], xf[..., half:]
    return jnp.concatenate([x1 * cos - x2 * sin, x2 * cos + x1 * sin], axis=-1).astype(x.dtype)


def fox_attention(q, k, v, logf):
    B, T, H, d = q.shape
    c = jnp.cumsum(logf, axis=1)
    c_key = c.transpose(0, 2, 1)
    nb = T // Q_BLOCK
    qb = q.reshape(B, nb, Q_BLOCK, H, d).transpose(1, 0, 2, 3, 4)
    cb = c.reshape(B, nb, Q_BLOCK, H).transpose(1, 0, 3, 2)
    kpos = jnp.arange(T)

    def body(args):
        i, qi, ci = args
        s = jnp.einsum('bqhd,bkhd->bhqk', qi, k, preferred_element_type=F32) * ATTN_SCALE
        s = s + ci[..., None] - c_key[:, :, None, :]
        qpos = i * Q_BLOCK + jnp.arange(Q_BLOCK)
        s = jnp.where((kpos[None, :] <= qpos[:, None])[None, None], s, -jnp.inf)
        p = jax.nn.softmax(s, axis=-1)
        return jnp.einsum('bhqk,bkhd->bqhd', p.astype(v.dtype), v)

    out = lax.map(body, (jnp.arange(nb), qb, cb))
    return out.transpose(1, 0, 2, 3, 4).reshape(B, T, H, d)


def dsa_attention(q, k, v, qi, ki, wi):
    B, T, H, d = q.shape
    topk = min(DSA_TOPK, T // 4)
    nb = T // Q_BLOCK
    kpos = jnp.arange(T)
    bidx = jnp.arange(B)[:, None, None]
    qbs = q.reshape(B, nb, Q_BLOCK, H, d).transpose(1, 0, 2, 3, 4)
    qib = qi.reshape(B, nb, Q_BLOCK, IDX_HEADS, IDX_DIM).transpose(1, 0, 2, 3, 4)
    wib = wi.reshape(B, nb, Q_BLOCK, IDX_HEADS).transpose(1, 0, 2, 3)

    def body(args):
        i, qq, qx, wx = args
        qpos = i * Q_BLOCK + jnp.arange(Q_BLOCK)
        rel = jax.nn.relu(jnp.einsum('bqhe,bke->bqhk', qx, ki, preferred_element_type=F32))
        score = jnp.einsum('bqh,bqhk->bqk', wx.astype(F32), rel)
        score = jnp.where((kpos[None, :] <= qpos[:, None])[None], score, -jnp.inf)
        _, idx = lax.top_k(score, topk)
        valid = idx <= qpos[None, :, None]
        kg = k[bidx, idx]
        vg = v[bidx, idx]
        s = jnp.einsum('bqhd,bqkhd->bhqk', qq, kg, preferred_element_type=F32) * ATTN_SCALE
        s = jnp.where(valid[:, None], s, -jnp.inf)
        p = jax.nn.softmax(s, axis=-1)
        return jnp.einsum('bhqk,bqkhd->bqhd', p.astype(v.dtype), vg)

    out = lax.map(body, (jnp.arange(nb), qbs, qib, wib))
    return out.transpose(1, 0, 2, 3, 4).reshape(B, T, H, d)


def dilated_attention(q, k, v):
    B, T, H, d = q.shape
    unit = Q_BLOCK * max(r for _, r in DIL_PATTERNS)
    Tp = -(-T // unit) * unit
    padw = ((0, 0), (0, Tp - T), (0, 0), (0, 0))
    qp, kp, vp = jnp.pad(q, padw), jnp.pad(k, padw), jnp.pad(v, padw)
    outs, lses = [], []
    for (w, r) in DIL_PATTERNS:
        n_sub = Tp // r
        nblk = n_sub // Q_BLOCK
        qs = qp.reshape(B, nblk, Q_BLOCK, r, H, d)
        ks = kp.reshape(B, nblk, Q_BLOCK, r, H, d)
        vs = vp.reshape(B, nblk, Q_BLOCK, r, H, d)
        kband = jnp.concatenate([jnp.concatenate([jnp.zeros_like(ks[:, :1]), ks[:, :-1]], axis=1), ks], axis=2)
        vband = jnp.concatenate([jnp.concatenate([jnp.zeros_like(vs[:, :1]), vs[:, :-1]], axis=1), vs], axis=2)
        s = jnp.einsum('bnqrhd,bnkrhd->bnrhqk', qs, kband, preferred_element_type=F32) * ATTN_SCALE
        qi = jnp.arange(Q_BLOCK)[:, None]
        kj = jnp.arange(2 * Q_BLOCK)[None, :]
        dist = qi + Q_BLOCK - kj
        band = (dist >= 0) & (dist <= w // r)
        exists = (jnp.arange(nblk)[:, None] * Q_BLOCK + jnp.arange(2 * Q_BLOCK)[None, :] - Q_BLOCK) >= 0
        mask = band[None] & exists[:, None, :]
        s = jnp.where(mask[None, :, None, None], s, -jnp.inf)
        m = jnp.max(s, axis=-1, keepdims=True)
        e = jnp.exp(s - m)
        den = jnp.sum(e, axis=-1)
        o = jnp.einsum('bnrhqk,bnkrhd->bnqrhd', e, vband.astype(F32)) / den.transpose(0, 1, 4, 2, 3)[..., None]
        lse = (m[..., 0] + jnp.log(den)).transpose(0, 1, 4, 2, 3)
        outs.append(o.reshape(B, Tp, H, d))
        lses.append(lse.reshape(B, Tp, H))
    wts = jax.nn.softmax(jnp.stack(lses, axis=0), axis=0)
    out = jnp.sum(wts[..., None] * jnp.stack(outs, axis=0), axis=0)
    return out[:, :T].astype(v.dtype)


def moba_attention(q, k, v):
    B, T, H, d = q.shape
    Tp = -(-T // MOBA_BLOCK) * MOBA_BLOCK
    padw = ((0, 0), (0, Tp - T), (0, 0), (0, 0))
    qp, kp, vp = jnp.pad(q, padw), jnp.pad(k, padw), jnp.pad(v, padw)
    nkb = Tp // MOBA_BLOCK
    topn = min(MOBA_TOPK, nkb)
    kb = kp.reshape(B, nkb, MOBA_BLOCK, H, d)
    vb = vp.reshape(B, nkb, MOBA_BLOCK, H, d)
    kmean = jnp.mean(kb.astype(F32), axis=2)
    kbt = kb.transpose(0, 3, 1, 2, 4)
    vbt = vb.transpose(0, 3, 1, 2, 4)
    nqb = Tp // MOBA_Q_BLOCK
    per = MOBA_BLOCK // MOBA_Q_BLOCK
    qbs = qp.reshape(B, nqb, MOBA_Q_BLOCK, H, d).transpose(1, 0, 2, 3, 4)
    bidx = jnp.arange(B)[:, None, None, None]
    hidx = jnp.arange(H)[None, None, :, None]
    blk_ids = jnp.arange(nkb)

    def body(args):
        i, qi = args
        own = i // per
        gate = jnp.einsum('bqhd,bnhd->bqhn', qi.astype(F32), kmean)
        gate = jnp.where(blk_ids < own, gate, -jnp.inf)
        _, sel = lax.top_k(gate, topn)
        valid = sel < own
        kg = kbt[bidx, hidx, sel]
        vg = vbt[bidx, hidx, sel]
        s_sel = jnp.einsum('bqhd,bqhnkd->bqhnk', qi, kg, preferred_element_type=F32) * ATTN_SCALE
        s_sel = jnp.where(valid[..., None], s_sel, -jnp.inf).reshape(B, MOBA_Q_BLOCK, H, topn * MOBA_BLOCK)
        kown = lax.dynamic_index_in_dim(kb, own, axis=1, keepdims=False)
        vown = lax.dynamic_index_in_dim(vb, own, axis=1, keepdims=False)
        s_own = jnp.einsum('bqhd,bkhd->bqhk', qi, kown, preferred_element_type=F32) * ATTN_SCALE
        qpos = i * MOBA_Q_BLOCK + jnp.arange(MOBA_Q_BLOCK)
        kpos = own * MOBA_BLOCK + jnp.arange(MOBA_BLOCK)
        s_own = jnp.where((kpos[None, :] <= qpos[:, None])[None, :, None, :], s_own, -jnp.inf)
        p = jax.nn.softmax(jnp.concatenate([s_sel, s_own], axis=-1), axis=-1)
        p_sel = p[..., :topn * MOBA_BLOCK].reshape(B, MOBA_Q_BLOCK, H, topn, MOBA_BLOCK)
        p_own = p[..., topn * MOBA_BLOCK:]
        o = jnp.einsum('bqhnk,bqhnkd->bqhd', p_sel.astype(v.dtype), vg) + \
            jnp.einsum('bqhk,bkhd->bqhd', p_own.astype(v.dtype), vown)
        return o.astype(v.dtype)

    out = lax.map(body, (jnp.arange(nqb), qbs))
    return out.transpose(1, 0, 2, 3, 4).reshape(B, Tp, H, d)[:, :T]


def hybrid_mixer(x, w_in, b_f, w_o):
    B, T, _ = x.shape
    pos = jnp.arange(T)
    proj = jnp.einsum('btd,de->bte', x, w_in)
    split_points = [int(s) for s in np.cumsum(SPLIT_SIZES)[:-1]]
    (qa, ka, va, fa, qb, kb, vb, qi, ki, wi, qc, kc, vc, qd, kd, vd) = jnp.split(proj, split_points, axis=-1)
    heads = lambda t: t.reshape(B, T, -1, HEAD_DIM)
    logf = jax.nn.log_sigmoid(fa.astype(F32) + b_f.astype(F32))
    oa = fox_attention(heads(qa), heads(ka), heads(va), logf)
    ob = dsa_attention(rope(heads(qb), pos), rope(heads(kb), pos), heads(vb),
                       rope(qi.reshape(B, T, IDX_HEADS, IDX_DIM), pos),
                       rope(ki[:, :, None, :], pos)[:, :, 0], wi)
    oc = dilated_attention(rope(heads(qc), pos), rope(heads(kc), pos), heads(vc))
    od = moba_attention(rope(heads(qd), pos), rope(heads(kd), pos), heads(vd))
    o = jnp.concatenate([t.reshape(B, T, -1).astype(x.dtype) for t in (oa, ob, oc, od)], axis=-1)
    return jnp.einsum('bte,ed->btd', o, w_o)


def setup_inputs(seed: int = 0) -> dict:
    key = jax.random.key(seed)
    ks = jax.random.split(key, 11)
    nrm = jax.random.normal
    x = nrm(ks[0], (BATCH, SEQ, D_MODEL), F32)
    w_in = nrm(ks[1], (DEPTH, D_MODEL, D_IN), F32) * D_MODEL ** -0.5
    b_f = 3.0 + 0.5 * nrm(ks[2], (DEPTH, H_FOX), F32)
    w_o = nrm(ks[3], (DEPTH, D_MODEL, D_MODEL), F32) * (D_MODEL ** -0.5 * DEEPNORM_BETA)
    ln1_g = 1.0 + 0.02 * nrm(ks[4], (DEPTH, D_MODEL), F32)
    ln1_b = 0.02 * nrm(ks[5], (DEPTH, D_MODEL), F32)
    w_up = nrm(ks[6], (DEPTH, D_MODEL, D_FF), F32) * D_MODEL ** -0.5
    w_down = nrm(ks[7], (DEPTH, D_FF, D_MODEL), F32) * (D_FF ** -0.5 * DEEPNORM_BETA)
    ln2_g = 1.0 + 0.02 * nrm(ks[8], (DEPTH, D_MODEL), F32)
    ln2_b = 0.02 * nrm(ks[9], (DEPTH, D_MODEL), F32)
    return {"x": x, "w_in": w_in, "b_f": b_f, "w_o": w_o, "ln1_g": ln1_g, "ln1_b": ln1_b,
            "w_up": w_up, "w_down": w_down, "ln2_g": ln2_g, "ln2_b": ln2_b}


def reference(x, w_in, b_f, w_o, ln1_g, ln1_b, w_up, w_down, ln2_g, ln2_b):
    for l in range(DEPTH):
        x = layer_norm(DEEPNORM_ALPHA * x + hybrid_mixer(x, w_in[l], b_f[l], w_o[l]), ln1_g[l], ln1_b[l])
        h = jnp.square(jax.nn.relu(jnp.einsum('btd,df->btf', x, w_up[l])))
        x = layer_norm(DEEPNORM_ALPHA * x + jnp.einsum('btf,fd->btd', h, w_down[l]), ln2_g[l], ln2_b[l])
    return x
```

```cpp
#include <hip/hip_runtime.h>
#include <hip/hip_cooperative_groups.h>
#include <cstdio>
#include <cstdint>
namespace cg = cooperative_groups;

#ifndef ONE_LAUNCH
#define ONE_LAUNCH 1
#endif

#ifndef SELFCHECK
#define SELFCHECK 0
#endif
#ifndef REPEAT_MASK
#define REPEAT_MASK 0
#endif
#ifndef PHASE_MASK
#define PHASE_MASK 0x1ff
#endif
#define HAS(s_) ((PHASE_MASK >> (s_)) & 1)
#define DI __device__ __forceinline__
typedef unsigned short u16;
typedef unsigned long long u64;
typedef __attribute__((ext_vector_type(8))) short bf16x8;
typedef __attribute__((ext_vector_type(4))) short s16x4;
typedef __attribute__((ext_vector_type(16))) float f32x16;
typedef __attribute__((ext_vector_type(4))) float f32x4;
typedef __attribute__((ext_vector_type(2))) float f32x2;
typedef __attribute__((ext_vector_type(2))) __bf16 bf16x2_t;
typedef __attribute__((address_space(3))) const char* lds_cptr;
typedef short v4i16_t __attribute__((ext_vector_type(4)));
typedef __attribute__((ext_vector_type(4))) unsigned u32x4;

#define MFMA32(a, b, c) __builtin_amdgcn_mfma_f32_32x32x16_bf16((a), (b), (c), 0, 0, 0)
#define MFMA16(a, b, c) __builtin_amdgcn_mfma_f32_16x16x32_bf16((a), (b), (c), 0, 0, 0)

constexpr int kB = 4, kT = 8192, kD = 1024, kM = kB * kT, kDepth = 4;
constexpr int kNQKV = 3072, kNPAD = 3456, kDFF = 4096, kDIN = 3372;
constexpr float kAlpha = 1.6817928305074290f;
constexpr float kLog2e = 1.4426950408889634f;
constexpr float kQScale = 0.125f * 1.4426950408889634f;
constexpr float kLnEps = 1e-5f;

constexpr size_t SZ_WIN = (size_t)kDepth * kNPAD * kD * 2;
constexpr size_t SZ_WO = (size_t)kDepth * kD * kD * 2;
constexpr size_t SZ_WUP = (size_t)kDepth * kDFF * kD * 2;
constexpr size_t SZ_WDN = SZ_WUP;
constexpr size_t SZ_XB = (size_t)kM * kD * 2;
constexpr size_t SZ_QKV = (size_t)kM * kNQKV * 2;
constexpr size_t SZ_O = (size_t)kM * kD * 2;
constexpr size_t SZ_MASK = (size_t)kM * 128 * 8;
constexpr size_t SZ_IDXQ = (size_t)kM * 256 * 2;
constexpr size_t SZ_IDXK = (size_t)kM * 32 * 2;
constexpr size_t SZ_WI = (size_t)kM * 8 * 4;
constexpr size_t SZ_LOGF = (size_t)kM * 4 * 4;
constexpr size_t SZ_CB = SZ_LOGF;
constexpr size_t SZ_KMEAN = (size_t)kB * 32 * 4 * 64 * 2;
constexpr size_t SZ_R32 = (size_t)kT * 32 * 2 * 4;
constexpr size_t SZ_R16 = (size_t)kT * 16 * 2 * 4;
constexpr size_t SZ_CNT = 8192;
constexpr size_t OFF_WIN = 0;
constexpr size_t OFF_WO = OFF_WIN + SZ_WIN;
constexpr size_t OFF_WUP = OFF_WO + SZ_WO;
constexpr size_t OFF_WDN = OFF_WUP + SZ_WUP;
constexpr size_t OFF_XB = OFF_WDN + SZ_WDN;
constexpr size_t OFF_QKV = OFF_XB + SZ_XB;
constexpr size_t OFF_O = OFF_QKV + SZ_QKV;
constexpr size_t OFF_MASK = OFF_O + SZ_O;
constexpr size_t OFF_IDXQ = OFF_MASK + SZ_MASK;
constexpr size_t OFF_IDXK = OFF_IDXQ + SZ_IDXQ;
constexpr size_t OFF_WI = OFF_IDXK + SZ_IDXK;
constexpr size_t OFF_LOGF = OFF_WI + SZ_WI;
constexpr size_t OFF_CB = OFF_LOGF + SZ_LOGF;
constexpr size_t OFF_KMEAN = OFF_CB + SZ_CB;
constexpr size_t OFF_R32 = OFF_KMEAN + SZ_KMEAN;
constexpr size_t OFF_R16 = OFF_R32 + SZ_R32;
constexpr size_t OFF_CNT = OFF_R16 + SZ_R16;
constexpr size_t OFF_BAR = OFF_CNT + SZ_CNT;
constexpr size_t SZ_BAR = 16384;
constexpr size_t OFF_KMAX = OFF_BAR + SZ_BAR;
constexpr size_t WS_TOTAL = OFF_KMAX + 256;

constexpr int LDS_BYTES = 65536 + 4096 + 2048 + 4096 + 64;

struct Params {
  const float* x; const float* w_in; const float* b_f; const float* w_o; const float* ln1_g; const float* ln1_b;
  const float* w_up; const float* w_down; const float* ln2_g; const float* ln2_b;
  float* out; char* ws;
  int phase_begin, phase_end, coop, pad;
};

DI unsigned pack2(float a, float b) { f32x2 v = {a, b}; bf16x2_t r = __builtin_convertvector(v, bf16x2_t); return __builtin_bit_cast(unsigned, r); }
DI u16 f2bf(float a) { return (u16)(pack2(a, 0.f) & 0xffffu); }
DI int crow(int r, int hi) { return (r & 3) + 8 * (r >> 2) + 4 * hi; }
DI s16x4 vtr(lds_cptr p) { return __builtin_bit_cast(s16x4, __builtin_amdgcn_ds_read_tr16_b64_v4i16((__attribute__((address_space(3))) v4i16_t*)p)); }
DI float ex2(float x) { return __builtin_amdgcn_exp2f(x); }
DI unsigned okey(float f) { unsigned u = __float_as_uint(f); return (u & 0x80000000u) ? ~u : (u | 0x80000000u); }

DI int tidx() { int t = threadIdx.x; asm volatile("" : "+v"(t)); return t; }
DI char* wsp(const Params& p) { size_t z = 0; asm volatile("" : "+s"(z)); return p.ws + z; }
DI float* outp(const Params& p) { size_t z = 0; asm volatile("" : "+s"(z)); return p.out + z; }

DI int refcol(int n) {
  if (n < 768) return n;
  if (n < 1536) return n + 4;
  if (n < 2304) return 1836 + (n - 1536);
  if (n < 3072) return 2604 + (n - 2304);
  if (n < 3328) return 1540 + (n - 3072);
  if (n < 3360) return 1796 + (n - 3328);
  if (n < 3368) return 1828 + (n - 3360);
  if (n < 3372) return 768 + (n - 3368);
  return -1;
}

DI void convert_tile(const float* __restrict__ src, int Nsrc, u16* __restrict__ dst, int K, int n0, int k0, bool remap, float* lds) {
  const int tid = tidx();
#pragma unroll 4
  for (int e = 0; e < 16; ++e) {
    const int idx = tid + 256 * e; const int k = idx >> 6, n = idx & 63;
    const int c = remap ? refcol(n0 + n) : (n0 + n);
    const float v = (c >= 0) ? src[(size_t)(k0 + k) * Nsrc + c] : 0.f;
    lds[k * 65 + n] = v;
  }
  __syncthreads();
#pragma unroll
  for (int e = 0; e < 2; ++e) {
    const int idx = tid + 256 * e; const int n = idx >> 3, ch = idx & 7;
    uint4 o;
    o.x = pack2(lds[(ch * 8 + 0) * 65 + n], lds[(ch * 8 + 1) * 65 + n]);
    o.y = pack2(lds[(ch * 8 + 2) * 65 + n], lds[(ch * 8 + 3) * 65 + n]);
    o.z = pack2(lds[(ch * 8 + 4) * 65 + n], lds[(ch * 8 + 5) * 65 + n]);
    o.w = pack2(lds[(ch * 8 + 6) * 65 + n], lds[(ch * 8 + 7) * 65 + n]);
    *(uint4*)(dst + (size_t)(n0 + n) * K + k0 + ch * 8) = o;
  }
  __syncthreads();
}

DI void init_phase(const Params& p, char* lds) {
  char* ws = wsp(p);
  constexpr int per_layer = 864 + 256 + 1024 + 1024;
  for (int idx = blockIdx.x; idx < per_layer * kDepth; idx += gridDim.x) {
    const int l = idx / per_layer; int r = idx % per_layer;
    if (r < 864) {
      convert_tile(p.w_in + (size_t)l * kD * kDIN, kDIN, (u16*)(ws + OFF_WIN) + (size_t)l * kNPAD * kD, kD, (r / 16) * 64, (r % 16) * 64, true, (float*)lds);
    } else if (r < 1120) {
      r -= 864;
      convert_tile(p.w_o + (size_t)l * kD * kD, kD, (u16*)(ws + OFF_WO) + (size_t)l * kD * kD, kD, (r / 16) * 64, (r % 16) * 64, false, (float*)lds);
    } else if (r < 2144) {
      r -= 1120;
      convert_tile(p.w_up + (size_t)l * kD * kDFF, kDFF, (u16*)(ws + OFF_WUP) + (size_t)l * kDFF * kD, kD, (r / 16) * 64, (r % 16) * 64, false, (float*)lds);
    } else {
      r -= 2144;
      convert_tile(p.w_down + (size_t)l * kDFF * kD, kD, (u16*)(ws + OFF_WDN) + (size_t)l * kD * kDFF, kDFF, (r / 64) * 64, (r % 64) * 64, false, (float*)lds);
    }
  }
  {
    const float4* src = (const float4*)p.x; uint2* xb = (uint2*)(ws + OFF_XB);
    const size_t n4 = (size_t)kM * kD / 4;
    for (size_t i = (size_t)blockIdx.x * 256 + tidx(); i < n4; i += (size_t)gridDim.x * 256) {
      const float4 v = src[i]; uint2 o; o.x = pack2(v.x, v.y); o.y = pack2(v.z, v.w); xb[i] = o;
    }
  }
  {
    float2* r32 = (float2*)(ws + OFF_R32); float2* r16 = (float2*)(ws + OFF_R16);
    for (int i = blockIdx.x * 256 + tidx(); i < kT * 48; i += gridDim.x * 256) {
      if (i < kT * 32) {
        const int t = i >> 5, f = i & 31; const float inv = powf(10000.0f, -(float)f / 32.0f); const float ang = (float)t * inv;
        double s, c; sincos((double)ang, &s, &c); r32[i] = make_float2((float)c, (float)s);
      } else {
        const int k = i - kT * 32; const int t = k >> 4, f = k & 15; const float inv = powf(10000.0f, -(float)f / 16.0f); const float ang = (float)t * inv;
        double s, c; sincos((double)ang, &s, &c); r16[k] = make_float2((float)c, (float)s);
      }
    }
  }
}

enum { EPI_INPROJ = 0, EPI_RESID = 1, EPI_RELU2 = 2 };

DI float logsigmoid(float z) { return fminf(z, 0.f) - log1pf(expf(-fabsf(z))); }

template <int EPI>
DI void gemm_tile(const Params& p, const u16* __restrict__ Wt, const u16* __restrict__ X, const int K, const int m0, const int n0, const int layer, char* lds) {
  const int tid = tidx(), lane = tid & 63, wid = tid >> 6, r32 = lane & 31, hi = lane >> 5;
  const int wm = wid & 1, wn = wid >> 1;
  f32x16 acc[2][4];
#pragma unroll
  for (int i = 0; i < 2; ++i)
#pragma unroll
    for (int j = 0; j < 4; ++j)
#pragma unroll
      for (int r = 0; r < 16; ++r) acc[i][j][r] = 0.f;
  char* Ws = lds; char* Xs = lds + 18432;
  const int srow = tid >> 3, sch = tid & 7;
  const u16* wsrc = Wt + (size_t)(n0 + srow) * K + sch * 8;
  const u16* xsrc = X + (size_t)(m0 + srow) * K + sch * 8;
  u32x4 w0, w1, w2, w3, x0, x1, x2, x3, x4, x5, x6, x7;
#define GLD(e, koff) *(const u32x4*)(wsrc + (size_t)(32 * (e)) * K + (koff))
#define GLDX(e, koff) *(const u32x4*)(xsrc + (size_t)(32 * (e)) * K + (koff))
  w0 = GLD(0, 0); w1 = GLD(1, 0); w2 = GLD(2, 0); w3 = GLD(3, 0);
  x0 = GLDX(0, 0); x1 = GLDX(1, 0); x2 = GLDX(2, 0); x3 = GLDX(3, 0); x4 = GLDX(4, 0); x5 = GLDX(5, 0); x6 = GLDX(6, 0); x7 = GLDX(7, 0);
  const int nk = K >> 6;
  for (int kt = 0; kt < nk; ++kt) {
    __syncthreads();
    *(u32x4*)(Ws + (srow + 0) * 144 + sch * 16) = w0; *(u32x4*)(Ws + (srow + 32) * 144 + sch * 16) = w1;
    *(u32x4*)(Ws + (srow + 64) * 144 + sch * 16) = w2; *(u32x4*)(Ws + (srow + 96) * 144 + sch * 16) = w3;
    *(u32x4*)(Xs + (srow + 0) * 144 + sch * 16) = x0; *(u32x4*)(Xs + (srow + 32) * 144 + sch * 16) = x1;
    *(u32x4*)(Xs + (srow + 64) * 144 + sch * 16) = x2; *(u32x4*)(Xs + (srow + 96) * 144 + sch * 16) = x3;
    *(u32x4*)(Xs + (srow + 128) * 144 + sch * 16) = x4; *(u32x4*)(Xs + (srow + 160) * 144 + sch * 16) = x5;
    *(u32x4*)(Xs + (srow + 192) * 144 + sch * 16) = x6; *(u32x4*)(Xs + (srow + 224) * 144 + sch * 16) = x7;
    __syncthreads();
    if (kt + 1 < nk) {
      const int ko = (kt + 1) * 64;
      w0 = GLD(0, ko); w1 = GLD(1, ko); w2 = GLD(2, ko); w3 = GLD(3, ko);
      x0 = GLDX(0, ko); x1 = GLDX(1, ko); x2 = GLDX(2, ko); x3 = GLDX(3, ko); x4 = GLDX(4, ko); x5 = GLDX(5, ko); x6 = GLDX(6, ko); x7 = GLDX(7, ko);
    }
#pragma unroll
    for (int kk = 0; kk < 4; ++kk) {
      bf16x8 wf[2], xf[4];
#pragma unroll
      for (int i = 0; i < 2; ++i) wf[i] = *(const bf16x8*)(Ws + (wn * 64 + i * 32 + r32) * 144 + kk * 32 + hi * 16);
#pragma unroll
      for (int j = 0; j < 4; ++j) xf[j] = *(const bf16x8*)(Xs + (wm * 128 + j * 32 + r32) * 144 + kk * 32 + hi * 16);
#pragma unroll
      for (int i = 0; i < 2; ++i)
#pragma unroll
        for (int j = 0; j < 4; ++j) acc[i][j] = MFMA32(wf[i], xf[j], acc[i][j]);
    }
  }
  const int nb = n0 + wn * 64, mb = m0 + wm * 128;
  char* ws = wsp(p);
  __syncthreads();
  char* stg = lds + wid * 9216;
  if (EPI == EPI_RESID) {
    float* out = outp(p);
    const bool first_res = (layer == 0 && K == kD);
    const u16* xbres = (const u16*)(ws + OFF_XB);
#pragma unroll
    for (int j = 0; j < 4; ++j) {
#pragma unroll
      for (int i = 0; i < 2; ++i)
#pragma unroll
        for (int g = 0; g < 4; ++g) {
          f32x4 v = {acc[i][j][4 * g + 0], acc[i][j][4 * g + 1], acc[i][j][4 * g + 2], acc[i][j][4 * g + 3]};
          *(f32x4*)(stg + r32 * 272 + (i * 32 + 8 * g + 4 * hi) * 4) = v;
        }
      __builtin_amdgcn_fence(__ATOMIC_RELEASE, "wavefront");
#pragma unroll
      for (int it = 0; it < 8; ++it) {
        const int row = it * 4 + (lane >> 4), ch = lane & 15;
        const f32x4 a = *(const f32x4*)(stg + row * 272 + ch * 16);
        const size_t eo = (size_t)(mb + j * 32 + row) * kD + nb + ch * 4;
        f32x4 v;
        if (first_res) v = *(const f32x4*)(p.x + eo);
        else { const uint2 xv = *(const uint2*)(xbres + eo); v = (f32x4){__uint_as_float(xv.x << 16), __uint_as_float(xv.x & 0xffff0000u), __uint_as_float(xv.y << 16), __uint_as_float(xv.y & 0xffff0000u)}; }
        v = v * kAlpha + a;
        *(f32x4*)(out + eo) = v;
      }
      __builtin_amdgcn_fence(__ATOMIC_RELEASE, "wavefront");
    }
  } else if (EPI == EPI_RELU2) {
    u16* H = (u16*)(ws + OFF_QKV);
#pragma unroll
    for (int jp = 0; jp < 2; ++jp) {
#pragma unroll
      for (int jj = 0; jj < 2; ++jj)
#pragma unroll
        for (int i = 0; i < 2; ++i)
#pragma unroll
          for (int g = 0; g < 4; ++g) {
            const int j = jp * 2 + jj;
            float a0 = fmaxf(acc[i][j][4 * g + 0], 0.f), a1 = fmaxf(acc[i][j][4 * g + 1], 0.f), a2 = fmaxf(acc[i][j][4 * g + 2], 0.f), a3 = fmaxf(acc[i][j][4 * g + 3], 0.f);
            uint2 o; o.x = pack2(a0 * a0, a1 * a1); o.y = pack2(a2 * a2, a3 * a3);
            *(uint2*)(stg + (jj * 32 + r32) * 144 + (i * 32 + 8 * g + 4 * hi) * 2) = o;
          }
      __builtin_amdgcn_fence(__ATOMIC_RELEASE, "wavefront");
#pragma unroll
      for (int it = 0; it < 8; ++it) {
        const int row = it * 8 + (lane >> 3), ch = lane & 7;
        const u32x4 v = *(const u32x4*)(stg + row * 144 + ch * 16);
        *(u32x4*)(H + (size_t)(mb + jp * 64 + row) * kDFF + nb + ch * 8) = v;
      }
      __builtin_amdgcn_fence(__ATOMIC_RELEASE, "wavefront");
    }
  } else {
    u16* QKV = (u16*)(ws + OFF_QKV); u16* IDXQ = (u16*)(ws + OFF_IDXQ); u16* IDXK = (u16*)(ws + OFF_IDXK);
    float* WI = (float*)(ws + OFF_WI); float* LOGF = (float*)(ws + OFF_LOGF);
    const float* rope32 = (const float*)(ws + OFF_R32); const float* rope16 = (const float*)(ws + OFF_R16);
    if (nb < kNQKV) {
      const int seg = nb >> 8; const int typ = seg % 3; const bool dorope = (seg >= 3) && (typ != 2);
      const float sc = (typ == 0) ? kQScale : 1.f;
#pragma unroll
      for (int jp = 0; jp < 2; ++jp) {
#pragma unroll
        for (int jj = 0; jj < 2; ++jj) {
          const int j = jp * 2 + jj;
          const int m = mb + j * 32 + r32; const int t = m & (kT - 1);
#pragma unroll
          for (int g = 0; g < 4; ++g) {
            float a0[4], a1[4];
#pragma unroll
            for (int e = 0; e < 4; ++e) { a0[e] = acc[0][j][4 * g + e]; a1[e] = acc[1][j][4 * g + e]; }
            if (dorope) {
              const float4* rp = (const float4*)(rope32 + ((size_t)t * 32 + 8 * g + 4 * hi) * 2);
              const float4 c01 = rp[0], c23 = rp[1];
              const float cs[4] = {c01.x, c01.z, c23.x, c23.z}; const float sn[4] = {c01.y, c01.w, c23.y, c23.w};
#pragma unroll
              for (int e = 0; e < 4; ++e) { const float x1 = a0[e], x2 = a1[e]; a0[e] = x1 * cs[e] - x2 * sn[e]; a1[e] = x2 * cs[e] + x1 * sn[e]; }
            }
            uint2 o0, o1;
            o0.x = pack2(a0[0] * sc, a0[1] * sc); o0.y = pack2(a0[2] * sc, a0[3] * sc);
            o1.x = pack2(a1[0] * sc, a1[1] * sc); o1.y = pack2(a1[2] * sc, a1[3] * sc);
            char* d = stg + (jj * 32 + r32) * 144 + (8 * g + 4 * hi) * 2;
            *(uint2*)d = o0; *(uint2*)(d + 64) = o1;
          }
        }
        __builtin_amdgcn_fence(__ATOMIC_RELEASE, "wavefront");
#pragma unroll
        for (int it = 0; it < 8; ++it) {
          const int row = it * 8 + (lane >> 3), ch = lane & 7;
          const u32x4 v = *(const u32x4*)(stg + row * 144 + ch * 16);
          *(u32x4*)(QKV + (size_t)(mb + jp * 64 + row) * kNQKV + nb + ch * 8) = v;
        }
        __builtin_amdgcn_fence(__ATOMIC_RELEASE, "wavefront");
      }
    } else if (nb <= 3328) {
#pragma unroll
      for (int j = 0; j < 4; ++j) {
        const int m = mb + j * 32 + r32; const int t = m & (kT - 1);
#pragma unroll
        for (int i = 0; i < 2; ++i) {
          if (nb == 3328 && i == 1) {
            float4 w; w.x = acc[1][j][0]; w.y = acc[1][j][1]; w.z = acc[1][j][2]; w.w = acc[1][j][3];
            *(float4*)(WI + (size_t)m * 8 + 4 * hi) = w;
            if (hi == 0) {
              const float* bf = p.b_f + layer * 4;
              float4 f;
              f.x = logsigmoid(acc[1][j][4] + bf[0]); f.y = logsigmoid(acc[1][j][5] + bf[1]);
              f.z = logsigmoid(acc[1][j][6] + bf[2]); f.w = logsigmoid(acc[1][j][7] + bf[3]);
              *(float4*)(LOGF + (size_t)m * 4) = f;
            }
          } else {
#pragma unroll
            for (int gg = 0; gg < 2; ++gg) {
              const float4* rp = (const float4*)(rope16 + ((size_t)t * 16 + 8 * gg + 4 * hi) * 2);
              const float4 c01 = rp[0], c23 = rp[1];
              const float cs[4] = {c01.x, c01.z, c23.x, c23.z}; const float sn[4] = {c01.y, c01.w, c23.y, c23.w};
              float o1[4], o2[4];
#pragma unroll
              for (int e = 0; e < 4; ++e) { const float x1 = acc[i][j][4 * gg + e], x2 = acc[i][j][4 * gg + 8 + e]; o1[e] = x1 * cs[e] - x2 * sn[e]; o2[e] = x2 * cs[e] + x1 * sn[e]; }
              uint2 p1, p2; p1.x = pack2(o1[0], o1[1]); p1.y = pack2(o1[2], o1[3]); p2.x = pack2(o2[0], o2[1]); p2.y = pack2(o2[2], o2[3]);
              u16* dst = (nb == 3328) ? (IDXK + (size_t)m * 32 + 8 * gg + 4 * hi) : (IDXQ + (size_t)m * 256 + (nb - kNQKV) + i * 32 + 8 * gg + 4 * hi);
              *(uint2*)dst = p1; *(uint2*)(dst + 16) = p2;
            }
          }
        }
      }
    }
  }
}
#undef GLD
#undef GLDX
struct XQ { unsigned* c; int step; unsigned xcc; };
DI int xq_pull(XQ& q, const int per_queue, int* slot, const int max_step) {
  for (;;) {
    if (q.step >= max_step) return -1;
    const int xq = (int)((q.xcc + (unsigned)q.step) & 7u);
    __syncthreads();
    if (threadIdx.x == 0) *slot = (int)atomicAdd(q.c + xq, 1u);
    __syncthreads();
    const int t = *slot;
    if (t < per_queue) return xq * per_queue + t;
    ++q.step;
  }
}

template <int EPI>
DI void gemm_phase(const Params& p, const u16* Wt, const u16* X, const int N, const int K, const int layer, char* lds, unsigned* qcnt, int* slot, const unsigned xcc) {
  const int ntn = N >> 7; const int per_queue = 16 * ntn;
  XQ q; q.c = qcnt; q.step = 0; q.xcc = xcc;
  for (int v = xq_pull(q, per_queue, slot, 8); v >= 0; v = xq_pull(q, per_queue, slot, 8)) {
    const int xq = v / per_queue, tk = v % per_queue;
    const int band = xq * 2 + tk / (8 * ntn); const int r = tk % (8 * ntn);
    const int nt = (r >> 6) * 8 + ((r & 63) >> 3), mt = band * 8 + (r & 7);
    gemm_tile<EPI>(p, Wt, X, K, mt * 256, nt * 128, layer, lds);
  }
}

DI float wave_sum(float v) {
#pragma unroll
  for (int off = 32; off > 0; off >>= 1) v += __shfl_xor(v, off);
  return v;
}
DI void ln_phase(const Params& p, const float* __restrict__ g, const float* __restrict__ bta, const bool last) {
  const int lane = tidx() & 63, wid = tidx() >> 6;
  float* x = outp(p); u16* xb = (u16*)(wsp(p) + OFF_XB);
  float4 gg[4], bb[4];
#pragma unroll
  for (int i = 0; i < 4; ++i) { gg[i] = *(const float4*)(g + (lane + 64 * i) * 4); bb[i] = *(const float4*)(bta + (lane + 64 * i) * 4); }
  for (int row = blockIdx.x * 4 + wid; row < kM; row += gridDim.x * 4) {
    float4* xr = (float4*)(x + (size_t)row * kD);
    float4 v[4]; float s = 0.f;
#pragma unroll
    for (int i = 0; i < 4; ++i) { v[i] = xr[lane + 64 * i]; s += v[i].x + v[i].y + v[i].z + v[i].w; }
    const float mean = wave_sum(s) * (1.0f / kD);
    float q = 0.f;
#pragma unroll
    for (int i = 0; i < 4; ++i) { v[i].x -= mean; v[i].y -= mean; v[i].z -= mean; v[i].w -= mean; q += v[i].x * v[i].x + v[i].y * v[i].y + v[i].z * v[i].z + v[i].w * v[i].w; }
    const float rstd = 1.0f / sqrtf(wave_sum(q) * (1.0f / kD) + kLnEps);
#pragma unroll
    for (int i = 0; i < 4; ++i) {
      float4 y;
      y.x = v[i].x * rstd * gg[i].x + bb[i].x; y.y = v[i].y * rstd * gg[i].y + bb[i].y;
      y.z = v[i].z * rstd * gg[i].z + bb[i].z; y.w = v[i].w * rstd * gg[i].w + bb[i].w;
      if (last) xr[lane + 64 * i] = y;
      uint2 o; o.x = pack2(y.x, y.y); o.y = pack2(y.z, y.w);
      if (!last) *(uint2*)(xb + (size_t)row * kD + (lane + 64 * i) * 4) = o;
    }
  }
}

DI void cumsum_item(const Params& p, const int bh, char* lds) {
  const int tid = tidx(); const int b = bh >> 2, h = bh & 3;
  const float* LOGF = (const float*)(wsp(p) + OFF_LOGF); float* CB = (float*)(wsp(p) + OFF_CB);
  float* part = (float*)lds;
  const float* src = LOGF + ((size_t)b * kT + tid * 32) * 4 + h;
  float s = 0.f;
  for (int i = 0; i < 32; ++i) s += src[i * 4];
  part[tid] = s;
  __syncthreads();
  float pre = 0.f;
  for (int i = 0; i < tid; ++i) pre += part[i];
  float run = pre;
  float* dst = CB + (size_t)bh * kT + tid * 32;
  for (int i = 0; i < 32; ++i) { run += src[i * 4]; dst[i] = run * kLog2e; }
  __syncthreads();
  {
    const u16* QKV = (const u16*)(wsp(p) + OFF_QKV);
    float mx = 0.f;
    for (int i = 0; i < 32; ++i) {
      const u16* kp = QKV + ((size_t)b * kT + tid * 32 + i) * kNQKV + 256 + h * 64;
      float ss = 0.f;
#pragma unroll
      for (int c = 0; c < 8; ++c) {
        const u32x4 v = *(const u32x4*)(kp + c * 8);
#pragma unroll
        for (int e = 0; e < 4; ++e) { const float a = __uint_as_float(v[e] << 16), bq = __uint_as_float(v[e] & 0xffff0000u); ss += a * a + bq * bq; }
      }
      mx = fmaxf(mx, ss);
    }
    part[tid] = mx;
    __syncthreads();
    if (tid == 0) { float m = 0.f; for (int i = 0; i < 256; ++i) m = fmaxf(m, part[i]); ((float*)(wsp(p) + OFF_KMAX))[bh] = sqrtf(m) * 1.002f; }
    __syncthreads();
  }
}

DI void kmean_item(const Params& p, const int idx) {
  const int tid = tidx(); const int b = idx >> 5, blk = idx & 31;
  const u16* QKV = (const u16*)(wsp(p) + OFF_QKV); u16* KMEAN = (u16*)(wsp(p) + OFF_KMEAN);
  const u16* src = QKV + ((size_t)b * kT + blk * 256) * kNQKV + 2560 + tid;
  float s = 0.f;
  for (int i = 0; i < 256; ++i) s += __uint_as_float((unsigned)src[(size_t)i * kNQKV] << 16);
  KMEAN[(((size_t)b * 32 + blk) * 4 + (tid >> 6)) * 64 + (tid & 63)] = f2bf(s * (1.0f / 256.0f));
}

#if SELFCHECK
DI void sc_flag2(const Params& p, unsigned idx) { atomicOr((unsigned*)(wsp(p) + OFF_CNT) + 200, 1u << idx); }
#endif
DI void select_item(const Params& p, const int b, const int t0, char* lds) {
  const int tid = tidx(), lane = tid & 63, wid = tid >> 6, r32 = lane & 31, hi = lane >> 5;
  u16* S16 = (u16*)lds; unsigned* hist = (unsigned*)(lds + 65536); u16* tl_idx = (u16*)(lds + 65536 + 4096); float* tl_sc = (float*)(lds + 65536 + 4096 + 2048);
  char* ws = wsp(p);
  const u16* IDXQ = (const u16*)(ws + OFF_IDXQ); const u16* IDXK = (const u16*)(ws + OFF_IDXK); const float* WI = (const float*)(ws + OFF_WI);
  u64* MASK = (u64*)(ws + OFF_MASK);
  const bool all = (t0 + 3 < 256);
  const int npad = (t0 | 127) + 1;
  const size_t rb = (size_t)b * kT;
  if (!all) {
    {
      const int hc = (r32 >> 2) & 1, ii = (r32 & 3) + 4 * (r32 >> 3);
      const int aq = 2 * hc + (ii >> 3), ah = ii & 7;
      const u16* ap = IDXQ + (rb + t0 + aq) * 256 + ah * 32 + hi * 8;
      const bf16x8 af0 = *(const bf16x8*)ap, af1 = *(const bf16x8*)(ap + 16);
      const float* wp = WI + (rb + t0 + 2 * hi) * 8;
      const float4 wa0 = *(const float4*)wp, wa1 = *(const float4*)(wp + 4), wb0 = *(const float4*)(wp + 8), wb1 = *(const float4*)(wp + 12);
      const int nchunks = (t0 + 4 + 31) >> 5;
      const u16* kp = IDXK + (rb + r32) * 32 + hi * 8;
      u16* s_a = S16 + (2 * hi) * 8192 + r32; u16* s_b = s_a + 8192;
      for (int c0 = wid; c0 < nchunks; c0 += 32) {
        bf16x8 k0[8], k1[8];
#pragma unroll
        for (int u = 0; u < 8; ++u) { const int c = min(c0 + 4 * u, nchunks - 1); const u16* q_ = kp + (size_t)c * 32 * 32; k0[u] = *(const bf16x8*)q_; k1[u] = *(const bf16x8*)(q_ + 16); }
        __builtin_amdgcn_sched_barrier(0);
#pragma unroll
        for (int u = 0; u < 8; ++u) {
          const int c = c0 + 4 * u;
          if (c < nchunks) {
            f32x16 acc;
#pragma unroll
            for (int r = 0; r < 16; ++r) acc[r] = 0.f;
            acc = MFMA32(af0, k0[u], acc); acc = MFMA32(af1, k1[u], acc);
            float sa = wa0.x * fmaxf(acc[0], 0.f) + wa0.y * fmaxf(acc[1], 0.f) + wa0.z * fmaxf(acc[2], 0.f) + wa0.w * fmaxf(acc[3], 0.f)
                     + wa1.x * fmaxf(acc[4], 0.f) + wa1.y * fmaxf(acc[5], 0.f) + wa1.z * fmaxf(acc[6], 0.f) + wa1.w * fmaxf(acc[7], 0.f);
            float sb = wb0.x * fmaxf(acc[8], 0.f) + wb0.y * fmaxf(acc[9], 0.f) + wb0.z * fmaxf(acc[10], 0.f) + wb0.w * fmaxf(acc[11], 0.f)
                     + wb1.x * fmaxf(acc[12], 0.f) + wb1.y * fmaxf(acc[13], 0.f) + wb1.z * fmaxf(acc[14], 0.f) + wb1.w * fmaxf(acc[15], 0.f);
            s_a[c * 32] = (u16)(okey(sa + 0.0f) >> 16); s_b[c * 32] = (u16)(okey(sb + 0.0f) >> 16);
          }
        }
      }
    }
    __syncthreads();
  }
  {
    const int q = wid; const int tq = t0 + q; const int nq = tq + 1;
    u16* Sq = S16 + q * 8192; unsigned* hq = hist + q * 256; u16* li = tl_idx + q * 256; float* ls = tl_sc + q * 256; float* qf32 = (float*)hq;
    unsigned thr = 0;
    if (!all) {
      unsigned prefix = 0; int krem = 256; unsigned cnt_eq = 0;
#pragma unroll
      for (int pass = 0; pass < 2; ++pass) {
        { const unsigned z0 = (unsigned)tid >> 30; u32x4 zz = {z0, z0, z0, z0}; *(u32x4*)(hq + lane * 4) = zz; }
        asm volatile("s_waitcnt lgkmcnt(0)" ::: "memory");
        for (int i = lane * 8; i < nq; i += 512) {
          const u32x4 v = *(const u32x4*)(Sq + i);
#pragma unroll
          for (int e = 0; e < 8; ++e) {
            if (i + e < nq) {
              const unsigned key = (e & 1) ? (v[e >> 1] >> 16) : (v[e >> 1] & 0xffffu);
              const bool match = (pass == 0) ? true : ((key >> 8) == prefix);
              if (match) atomicAdd(&hq[(pass == 0) ? (key >> 8) : (key & 255u)], 1u);
            }
          }
        }
        asm volatile("s_waitcnt lgkmcnt(0)" ::: "memory");
        const u32x4 c = *(const u32x4*)(hq + 4 * lane);
        const unsigned s_ = c[0] + c[1] + c[2] + c[3]; unsigned incl = s_;
#pragma unroll
        for (int off = 1; off < 64; off <<= 1) { const unsigned v = __shfl_down(incl, off); if (lane + off < 64) incl += v; }
        const unsigned excl = incl - s_;
        const bool has = (excl < (unsigned)krem) && (incl >= (unsigned)krem);
        unsigned bsel = 0, above = 0, cbin = 0;
        {
          unsigned cum = excl;
          if (cum + c[3] >= (unsigned)krem) { bsel = 4 * lane + 3; above = cum; cbin = c[3]; }
          else { cum += c[3];
            if (cum + c[2] >= (unsigned)krem) { bsel = 4 * lane + 2; above = cum; cbin = c[2]; }
            else { cum += c[2];
              if (cum + c[1] >= (unsigned)krem) { bsel = 4 * lane + 1; above = cum; cbin = c[1]; }
              else { cum += c[1]; bsel = 4 * lane; above = cum; cbin = c[0]; } } }
        }
        const u64 bm = __ballot(has); const int srcl = bm ? (__ffsll((long long)bm) - 1) : 0;
        bsel = __shfl(bsel, srcl); above = __shfl(above, srcl); cbin = __shfl(cbin, srcl);
        prefix = (prefix << 8) | bsel; krem -= (int)above; cnt_eq = cbin;
      }
      thr = prefix;
#if SELFCHECK
      {
        int cg_ = 0, ce_ = 0;
        for (int base = 0; base < nq; base += 64) { const int j = base + lane; const unsigned kk_ = (j < nq) ? (unsigned)Sq[j] : 0u; cg_ += __popcll(__ballot(j < nq && kk_ > thr)); ce_ += __popcll(__ballot(j < nq && kk_ == thr)); }
        if (cg_ != 256 - krem) sc_flag2(p, 19);
        if ((unsigned)ce_ != cnt_eq) sc_flag2(p, 18);
      }
#endif
      if (cnt_eq != (unsigned)krem) {
        int nmem = 0;
        for (int i0 = 0; i0 < nq; i0 += 512) {
          const int i = i0 + lane * 8;
          unsigned mm = 0;
          if (i < nq) {
            const u32x4 v = *(const u32x4*)(Sq + i);
#pragma unroll
            for (int e = 0; e < 8; ++e) {
              const unsigned key = (e & 1) ? (v[e >> 1] >> 16) : (v[e >> 1] & 0xffffu);
              if (i + e < nq && key == thr) mm |= 1u << e;
            }
          }
          u64 anyb = __ballot(mm != 0u);
          while (anyb) {
            const int L = __ffsll((long long)anyb) - 1; anyb &= anyb - 1ull;
            const unsigned m8 = __shfl(mm, L);
#pragma unroll
            for (int e = 0; e < 8; ++e) {
              if ((m8 >> e) & 1u) { if (nmem < 256 && lane == 0) li[nmem] = (u16)(i0 + L * 8 + e); ++nmem; }
            }
          }
        }
        asm volatile("s_waitcnt lgkmcnt(0)" ::: "memory");
        if (nmem <= 256) {
          const float* wr = WI + (rb + tq) * 8;
          for (int m0_ = 0; m0_ < nmem; m0_ += 64) {
            const int m = m0_ + lane;
            if (m < nmem) {
              const int j = li[m];
              const u16* kr = IDXK + (rb + j) * 32;
              float tot = 0.f;
              const u16* qr = IDXQ + (rb + tq) * 256;
#pragma unroll 1
              for (int h = 0; h < 8; ++h) {
                float d_ = 0.f;
#pragma unroll
                for (int c = 0; c < 4; ++c) {
                  const u32x4 qv = *(const u32x4*)(qr + h * 32 + c * 8); const u32x4 kv_ = *(const u32x4*)(kr + c * 8);
#pragma unroll
                  for (int e = 0; e < 4; ++e)
                    d_ += __uint_as_float(qv[e] << 16) * __uint_as_float(kv_[e] << 16) + __uint_as_float(qv[e] & 0xffff0000u) * __uint_as_float(kv_[e] & 0xffff0000u);
                }
                tot += wr[h] * fmaxf(d_, 0.f);
              }
              ls[m] = tot + 0.0f;
            }
          }
          asm volatile("s_waitcnt lgkmcnt(0)" ::: "memory");
          for (int m0_ = 0; m0_ < nmem; m0_ += 64) {
            const int m = m0_ + lane;
            if (m < nmem) {
              const float sm = ls[m]; const int jm = li[m]; int rank = 0;
              for (int o = 0; o < nmem; ++o) { const float so = ls[o]; const int jo = li[o]; rank += (so > sm || (so == sm && jo < jm)) ? 1 : 0; }
              if (rank < krem) Sq[jm] = (u16)0xFFFFu;
            }
          }
        } else {
          int taken = 0;
          for (int base = 0; base < nq; base += 64) {
            const int j = base + lane;
            const bool mem = (j < nq) && ((unsigned)Sq[j < nq ? j : 0] == thr);
            const u64 mb = __ballot(mem);
            if (mem) { const int pos = taken + __popcll(mb & ((1ull << lane) - 1ull)); if (pos < krem) Sq[j] = (u16)0xFFFFu; }
            taken += __popcll(mb);
          }
        }
        asm volatile("s_waitcnt lgkmcnt(0)" ::: "memory");
      } else {
        thr = thr - 1u;
      }
    }
    {
      const int nIt = (npad + 255) >> 8;
      int tot_bits = 0;
      u64* mbase = MASK + ((size_t)(b * 256 + (tq >> 5)) * 128) * 32 + (tq & 31);
      for (int it = 0; it < nIt; ++it) {
        const int kbase = it * 256 + lane * 4;
        unsigned k01 = 0, k23 = 0;
        if (!all) { const uint2 v = *(const uint2*)(Sq + kbase); k01 = v.x; k23 = v.y; }
        const unsigned kv[4] = {k01 & 0xffffu, k01 >> 16, k23 & 0xffffu, k23 >> 16};
        u64 gsel[4];
#pragma unroll
        for (int e = 0; e < 4; ++e) { const bool valid = (kbase + e) <= tq; gsel[e] = __ballot(valid && (all || kv[e] > thr)); }
        u64 wt[4];
#pragma unroll
        for (int tau = 0; tau < 4; ++tau) {
          u64 acc_ = 0;
#pragma unroll
          for (int e = 0; e < 4; ++e) acc_ |= ((gsel[e] >> (16 * tau)) & 0xFFFFull) << (16 * e);
          wt[tau] = acc_;
        }
        const u64 wv = (lane == 0) ? wt[0] : (lane == 1) ? wt[1] : (lane == 2) ? wt[2] : wt[3];
        const int tile = it * 4 + lane;
        if (lane < 4 && tile * 64 < npad) mbase[(size_t)tile * 32] = wv;
#if SELFCHECK
        tot_bits += __popcll(gsel[0]) + __popcll(gsel[1]) + __popcll(gsel[2]) + __popcll(gsel[3]);
#endif
      }
#if SELFCHECK
      if (!all && tot_bits != 256) sc_flag2(p, 16);
      if (!all && tot_bits > 256 + 64) sc_flag2(p, 17);
#endif
    }
  }
  __syncthreads();
}

enum { M_FOX = 0, M_DSA = 1, M_DIL = 2, M_MOBA = 3 };

template <int MODE>
DI void attn_item(const Params& p, const int b, const int h, const int sub, char* lds) {
  const int tid = tidx(), lane = tid & 63, wid = tid >> 6, r32 = lane & 31, hi = lane >> 5;
  char* ws = wsp(p);
  const u16* QKV = (const u16*)(ws + OFF_QKV); u16* O = (u16*)(ws + OFF_O);
  constexpr int grp = MODE;
  const int qcol = grp * 768 + h * 64, kcol = qcol + 256, vcol = qcol + 512;
  const size_t rowbase = (size_t)b * kT;
  int tq, tw_lo, tw_hi, qt = 0, it = 0, res16 = 0;
  if (MODE == M_DIL) { res16 = sub >> 4; it = sub & 15; tq = (it * 32 + r32) * 16 + res16 + 4 * wid; tw_lo = (it * 32) * 16 + res16 + 4 * wid; tw_hi = tw_lo + 31 * 16; }
  else { qt = sub; tq = qt * 128 + wid * 32 + r32; tw_lo = qt * 128 + wid * 32; tw_hi = tw_lo + 31; }
  bf16x8 qf[4];
  {
    const u16* qp = QKV + (rowbase + tq) * kNQKV + qcol + hi * 8;
#pragma unroll
    for (int d0 = 0; d0 < 4; ++d0) qf[d0] = *(const bf16x8*)(qp + d0 * 16);
  }
  const int ntiles = (MODE == M_DIL) ? 26 : (2 * qt + 2);
  unsigned selmask = 0;
  if (MODE == M_MOBA) {
    const int own = qt >> 1;
    const u16* KMEAN = (const u16*)(ws + OFF_KMEAN);
    f32x16 g;
#pragma unroll
    for (int r = 0; r < 16; ++r) g[r] = 0.f;
#pragma unroll
    for (int d0 = 0; d0 < 4; ++d0) {
      const bf16x8 kmf = *(const bf16x8*)(KMEAN + (((size_t)b * 32 + r32) * 4 + h) * 64 + d0 * 16 + hi * 8);
      g = MFMA32(kmf, qf[d0], g);
    }
#pragma unroll
    for (int round = 0; round < 3; ++round) {
      float best = -INFINITY; int bi = 99;
#pragma unroll
      for (int r = 0; r < 16; ++r) {
        const int n = crow(r, hi);
        if (n < own && !((selmask >> n) & 1u) && g[r] > best) { best = g[r]; bi = n; }
      }
      const float ob = __shfl_xor(best, 32); const int obi = __shfl_xor(bi, 32);
      if (ob > best || (ob == best && obi < bi)) { best = ob; bi = obi; }
      if (bi < 32) selmask |= (1u << bi);
    }
    selmask |= (1u << own);
  }
  const u64* mrow = (const u64*)(ws + OFF_MASK) + ((size_t)(b * 256 + (tq >> 5)) * 128) * 32 + (tq & 31);
  const float* cbp = (const float*)(ws + OFF_CB) + (size_t)(b * 4 + h) * kT;

  float m_run = -INFINITY, l_run = 0.f;
  f32x16 o0, o1;
#pragma unroll
  for (int r = 0; r < 16; ++r) { o0[r] = 0.f; o1[r] = 0.f; }
  char* Ks = lds; char* Vs = lds + 9216; float* CBs = (float*)(lds + 18432); float* AL = (float*)(lds + 18688 + wid * 128);
  const int srow = tid >> 3, sch = tid & 7;
  auto tile_desc = [&](const int j, int& lo, int& r) {
    if (MODE == M_DIL) {
      if (j < 12) { r = 16; lo = (it * 32 - 128 + 64 * (j % 3)) * 16 + res16 + 4 * (j / 3); }
      else if (j < 16) { r = 4; lo = (128 * it - 128 + 64 * (j - 12)) * 4 + res16; }
      else { r = 1; lo = 512 * it + res16 - 128 + 64 * (j - 16); }
    } else { r = 1; lo = 64 * j; }
  };
  u32x4 kr0, kr1, vr0, vr1; float cbreg = 0.f;
#define PREFETCH(jj) do { int lo_, r_; tile_desc((jj), lo_, r_); \
    { const int tpos = lo_ + srow * r_; \
      if (MODE != M_DIL || (tpos >= 0 && tpos < kT)) { const u16* base = QKV + (rowbase + tpos) * kNQKV + sch * 8; kr0 = *(const u32x4*)(base + kcol); vr0 = *(const u32x4*)(base + vcol); } \
      else { kr0 = (u32x4){0u, 0u, 0u, 0u}; vr0 = (u32x4){0u, 0u, 0u, 0u}; } } \
    { const int tpos = lo_ + (srow + 32) * r_; \
      if (MODE != M_DIL || (tpos >= 0 && tpos < kT)) { const u16* base = QKV + (rowbase + tpos) * kNQKV + sch * 8; kr1 = *(const u32x4*)(base + kcol); vr1 = *(const u32x4*)(base + vcol); } \
      else { kr1 = (u32x4){0u, 0u, 0u, 0u}; vr1 = (u32x4){0u, 0u, 0u, 0u}; } } \
    if (MODE == M_FOX) { if (tid < 64) cbreg = cbp[lo_ + tid]; } } while (0)
  float ubq = 0.f; bool wdone = false;
  if (MODE == M_FOX) {
    float ss = 0.f;
#pragma unroll
    for (int d0 = 0; d0 < 4; ++d0)
#pragma unroll
      for (int e = 0; e < 8; ++e) { const float a = __uint_as_float((unsigned)(unsigned short)qf[d0][e] << 16); ss += a * a; }
    ss += __shfl_xor(ss, 32);
    ubq = sqrtf(ss) * 1.002f * ((const float*)(ws + OFF_KMAX))[b * 4 + h];
  }
#define TILE_OF(j_) ((MODE == M_FOX) ? (ntiles - 1 - (j_)) : (j_))
  PREFETCH(TILE_OF(0));
  for (int j = 0; j < ntiles; ++j) {
    if (MODE == M_FOX) { if (__syncthreads_and(wdone ? 1 : 0)) break; }
    else __syncthreads();
    *(u32x4*)(Ks + srow * 144 + sch * 16) = kr0; *(u32x4*)(Ks + (srow + 32) * 144 + sch * 16) = kr1;
    *(u32x4*)(Vs + srow * 144 + sch * 16) = vr0; *(u32x4*)(Vs + (srow + 32) * 144 + sch * 16) = vr1;
    if (MODE == M_FOX) { if (tid < 64) CBs[tid] = -cbreg; }
    __syncthreads();
    int lo, rs; tile_desc(TILE_OF(j), lo, rs);
    if (j + 1 < ntiles) PREFETCH(TILE_OF(j + 1));
    __builtin_amdgcn_sched_barrier(0);
    bool part;
    if (MODE == M_DIL) part = (lo <= tw_hi) && (lo + 63 * rs >= tw_lo - 128 * rs) && (TILE_OF(j) >= 12 || TILE_OF(j) / 3 == wid);
    else part = (lo <= tw_hi);
    if (MODE == M_FOX) {
      if (part && !wdone) { const float bound = ubq + CBs[63]; if (__all((bound - m_run) < -140.0f)) wdone = true; }
      part = part && !wdone;
    }
    if (part) {
      f32x16 s0, s1;
      if (MODE == M_FOX) {
#pragma unroll
        for (int g = 0; g < 4; ++g) {
          const float4 c0 = *(const float4*)(CBs + 8 * g + 4 * hi); const float4 c1 = *(const float4*)(CBs + 32 + 8 * g + 4 * hi);
          s0[4 * g + 0] = c0.x; s0[4 * g + 1] = c0.y; s0[4 * g + 2] = c0.z; s0[4 * g + 3] = c0.w;
          s1[4 * g + 0] = c1.x; s1[4 * g + 1] = c1.y; s1[4 * g + 2] = c1.z; s1[4 * g + 3] = c1.w;
        }
      } else {
#pragma unroll
        for (int r = 0; r < 16; ++r) { s0[r] = 0.f; s1[r] = 0.f; }
      }
#pragma unroll
      for (int d0 = 0; d0 < 4; ++d0) {
        const bf16x8 k0 = *(const bf16x8*)(Ks + r32 * 144 + d0 * 32 + hi * 16);
        const bf16x8 k1 = *(const bf16x8*)(Ks + (32 + r32) * 144 + d0 * 32 + hi * 16);
        s0 = MFMA32(k0, qf[d0], s0); s1 = MFMA32(k1, qf[d0], s1);
      }
      bool row_ok = true;
      if (MODE == M_FOX || MODE == M_MOBA) {
        if (MODE == M_MOBA) row_ok = (selmask >> (lo >> 8)) & 1u;
        if (lo + 63 > tw_lo) {
#pragma unroll
          for (int r = 0; r < 16; ++r) {
            const int kp = lo + crow(r, hi);
            if (kp > tq) s0[r] = -INFINITY;
            if (kp + 32 > tq) s1[r] = -INFINITY;
          }
        }
      }
      if (MODE == M_DSA) {
        const u64 w = mrow[(size_t)j * 32];
#if SELFCHECK == 2
        const unsigned wl = ((unsigned)w & ~1u) >> hi, wh = (unsigned)(w >> 32) >> hi;
#else
        const unsigned wl = (unsigned)w >> hi, wh = (unsigned)(w >> 32) >> hi;
#endif
#pragma unroll
        for (int r = 0; r < 16; ++r) {
          const int e = r & 3, g = r >> 2;
          const unsigned word = (e < 2) ? wl : wh;
          const int bit = 16 * (e & 1) + 2 * g;
          const unsigned k0_ = (unsigned)__builtin_amdgcn_sbfe((int)word, bit, 1), k1_ = (unsigned)__builtin_amdgcn_sbfe((int)word, bit + 8, 1);
          s0[r] = __uint_as_float((__float_as_uint(s0[r]) & k0_) | (0xFF800000u & ~k0_));
          s1[r] = __uint_as_float((__float_as_uint(s1[r]) & k1_) | (0xFF800000u & ~k1_));
        }
      }
      if (MODE == M_DIL) {
        const unsigned lim = (unsigned)min(128 * rs, tq);
        const int dq = tq - lo - rs * 4 * hi;
#pragma unroll
        for (int r = 0; r < 16; ++r) {
          const int c_r = (r & 3) + 8 * (r >> 2);
          const int d0 = dq - rs * c_r, d1 = d0 - 32 * rs;
          if ((unsigned)d0 > lim) s0[r] = -INFINITY;
          if ((unsigned)d1 > lim) s1[r] = -INFINITY;
        }
      }
#define MX3(a_, b_, c_) __builtin_fmaxf(__builtin_fmaxf((a_), (b_)), (c_))
      float mxa = MX3(s0[0], s0[1], s1[0]), mxb = MX3(s0[2], s0[3], s1[1]); mxa = MX3(mxa, s1[2], s1[3]);
#pragma unroll
      for (int r = 4; r < 16; r += 4) { mxa = MX3(mxa, s0[r], s0[r + 1]); mxb = MX3(mxb, s0[r + 2], s0[r + 3]); mxa = MX3(mxa, s1[r], s1[r + 1]); mxb = MX3(mxb, s1[r + 2], s1[r + 3]); }
#undef MX3
      float mx = fmaxf(mxa, mxb);
      if (MODE == M_MOBA) mx = row_ok ? mx : -INFINITY;
      mx = fmaxf(mx, __shfl_xor(mx, 32));
      const float m_new = fmaxf(m_run, mx);
      const float m_safe = (m_new == -INFINITY) ? 0.f : m_new;
      const float alpha = ex2(m_run - m_safe);
      const float m_exp = (MODE == M_MOBA && !row_ok) ? INFINITY : m_safe;
      float sum = 0.f;
#pragma unroll
      for (int r = 0; r < 16; ++r) { s0[r] = ex2(s0[r] - m_exp); s1[r] = ex2(s1[r] - m_exp); sum += s0[r] + s1[r]; }
      l_run = l_run * alpha + sum; m_run = m_new;
      if (__any(alpha != 1.0f)) {
        if (hi == 0) AL[r32] = alpha;
        __builtin_amdgcn_fence(__ATOMIC_RELEASE, "wavefront");
#pragma unroll
        for (int g = 0; g < 4; ++g) {
          const float4 a4 = *(const float4*)(AL + 8 * g + 4 * hi);
          o0[4 * g + 0] *= a4.x; o0[4 * g + 1] *= a4.y; o0[4 * g + 2] *= a4.z; o0[4 * g + 3] *= a4.w;
          o1[4 * g + 0] *= a4.x; o1[4 * g + 1] *= a4.y; o1[4 * g + 2] *= a4.z; o1[4 * g + 3] *= a4.w;
        }
      }
      bf16x8 pa[4];
      {
        uint4 u;
        u.x = pack2(s0[0], s0[1]); u.y = pack2(s0[2], s0[3]); u.z = pack2(s0[4], s0[5]); u.w = pack2(s0[6], s0[7]); pa[0] = __builtin_bit_cast(bf16x8, u);
        u.x = pack2(s0[8], s0[9]); u.y = pack2(s0[10], s0[11]); u.z = pack2(s0[12], s0[13]); u.w = pack2(s0[14], s0[15]); pa[1] = __builtin_bit_cast(bf16x8, u);
        u.x = pack2(s1[0], s1[1]); u.y = pack2(s1[2], s1[3]); u.z = pack2(s1[4], s1[5]); u.w = pack2(s1[6], s1[7]); pa[2] = __builtin_bit_cast(bf16x8, u);
        u.x = pack2(s1[8], s1[9]); u.y = pack2(s1[10], s1[11]); u.z = pack2(s1[12], s1[13]); u.w = pack2(s1[14], s1[15]); pa[3] = __builtin_bit_cast(bf16x8, u);
      }
      {
        const int i16 = lane & 15, qq = i16 >> 2, pp = i16 & 3, blk = (lane >> 4) & 1;
        const lds_cptr vbase = (lds_cptr)Vs + (4 * hi + qq) * 144 + blk * 32 + pp * 8;
#pragma unroll
        for (int ks = 0; ks < 4; ++ks) {
#pragma unroll
          for (int dh = 0; dh < 2; ++dh) {
            const s16x4 lo4 = vtr(vbase + (ks * 16) * 144 + dh * 64);
            const s16x4 hi4 = vtr(vbase + (ks * 16 + 8) * 144 + dh * 64);
            const bf16x8 vf = __builtin_shufflevector(lo4, hi4, 0, 1, 2, 3, 4, 5, 6, 7);
            if (dh == 0) o0 = MFMA32(pa[ks], vf, o0); else o1 = MFMA32(pa[ks], vf, o1);
          }
        }
      }
    }
  }
  {
    const float l_tot = l_run + __shfl_xor(l_run, 32);
    if (hi == 0) AL[r32] = 1.0f / l_tot;
    __builtin_amdgcn_fence(__ATOMIC_RELEASE, "wavefront");
#pragma unroll
    for (int g = 0; g < 4; ++g) {
      const float4 a4 = *(const float4*)(AL + 8 * g + 4 * hi);
      const float av[4] = {a4.x, a4.y, a4.z, a4.w};
#pragma unroll
      for (int e = 0; e < 4; ++e) {
        const int qr = wid * 32 + 8 * g + 4 * hi + e;
        const int tqr = (MODE == M_DIL) ? ((it * 32 + (qr - wid * 32)) * 16 + res16 + 4 * wid) : (qt * 128 + qr);
        u16* dst = O + (rowbase + tqr) * kD + grp * 256 + h * 64 + r32;
        dst[0] = f2bf(o0[4 * g + e] * av[e]);
        dst[32] = f2bf(o1[4 * g + e] * av[e]);
      }
    }
  }
  __syncthreads();
}

#undef PREFETCH
#undef TILE_OF

#if SELFCHECK
DI float bf2f(u16 v) { return __uint_as_float((unsigned)v << 16); }
DI void sc_flag(const Params& p, unsigned idx) { atomicOr((unsigned*)(wsp(p) + OFF_CNT) + 200, 1u << idx); }
DI float blk_max(float v, float* red) {
  const int tid = tidx();
  red[tid] = v; __syncthreads();
  float m = -INFINITY; for (int i = 0; i < 256; ++i) m = fmaxf(m, red[i]);
  __syncthreads(); return m;
}
DI void check_attn(const Params& p, const int mode, const int b, const int t, const int h, char* lds) {
  const int tid = tidx();
  float* sc = (float*)lds; float* red = (float*)(lds + 32768); float* acc4 = (float*)(lds + 32768 + 1024); float* l4 = (float*)(lds + 32768 + 1024 + 1024);
  char* ws = wsp(p);
  const u16* QKV = (const u16*)(ws + OFF_QKV); const u16* O = (const u16*)(ws + OFF_O);
  const int qcol = mode * 768 + h * 64, kcol = qcol + 256, vcol = qcol + 512;
  const size_t rb = (size_t)b * kT;
  unsigned allowed = 0xffffffffu;
  if (mode == M_MOBA) {
    const int own = t >> 8; const u16* KMEAN = (const u16*)(ws + OFF_KMEAN);
    if (tid < 32) { float g = -INFINITY; if (tid < own) { g = 0.f; for (int d = 0; d < 64; ++d) g += bf2f(QKV[(rb + t) * kNQKV + qcol + d]) * bf2f(KMEAN[(((size_t)b * 32 + tid) * 4 + h) * 64 + d]); } red[tid] = g; }
    __syncthreads();
    allowed = 0;
    for (int round = 0; round < 3; ++round) { float best = -INFINITY; int bi = -1; for (int n = 0; n < own; ++n) if (!((allowed >> n) & 1u) && red[n] > best) { best = red[n]; bi = n; } if (bi >= 0) allowed |= 1u << bi; }
    allowed |= 1u << own;
    __syncthreads();
  }
  const int n = (mode == M_DIL) ? 387 : (t + 1);
  float lmax = -INFINITY;
  for (int e = tid; e < n; e += 256) {
    int j = e; bool ok = true; float bias = 0.f;
    if (mode == M_DIL) { const int pi = e / 129, i = e % 129; const int r = (pi == 0) ? 1 : (pi == 1 ? 4 : 16); j = t - i * r; ok = (j >= 0); }
    float sv = -INFINITY;
    if (ok) {
      if (mode == M_FOX) bias = -((const float*)(ws + OFF_CB))[(size_t)(b * 4 + h) * kT + j];
      if (mode == M_DSA) { const u64 w = ((const u64*)(ws + OFF_MASK))[((size_t)(b * 256 + (t >> 5)) * 128 + (j >> 6)) * 32 + (t & 31)]; const int kk = j & 63; ok = (w >> (16 * (kk & 3) + (kk >> 2))) & 1ull; }
      if (mode == M_MOBA) ok = (allowed >> (j >> 8)) & 1u;
      if (ok) { float d_ = 0.f; for (int d = 0; d < 64; ++d) d_ += bf2f(QKV[(rb + t) * kNQKV + qcol + d]) * bf2f(QKV[(rb + j) * kNQKV + kcol + d]); sv = d_ + bias; }
    }
    sc[e] = sv; lmax = fmaxf(lmax, sv);
  }
  __syncthreads();
  const float m = blk_max(lmax, red);
  const int d = tid & 63, part = tid >> 6;
  float acc = 0.f, l = 0.f;
  for (int e = part; e < n; e += 4) {
    const float sv = sc[e];
    if (sv > -INFINITY) {
      int j = e; if (mode == M_DIL) { const int pi = e / 129, i = e % 129; const int r = (pi == 0) ? 1 : (pi == 1 ? 4 : 16); j = t - i * r; }
      const float pe = exp2f(sv - m); acc += pe * bf2f(QKV[(rb + j) * kNQKV + vcol + d]); l += pe;
    }
  }
  acc4[tid] = acc; if (d == 0) l4[part] = l;
  __syncthreads();
  if (tid < 64) {
    const float o = (acc4[tid] + acc4[tid + 64] + acc4[tid + 128] + acc4[tid + 192]) / (l4[0] + l4[1] + l4[2] + l4[3]);
    const float got = bf2f(O[(rb + t) * kD + mode * 256 + h * 64 + tid]);
    if (!(fabsf(got - o) <= 0.003f + 0.012f * fabsf(o))) sc_flag(p, mode);
  }
  __syncthreads();
}
DI void check_select(const Params& p, const int b, const int t, char* lds) {
  const int tid = tidx(); char* ws = wsp(p);
  float* sc = (float*)lds; unsigned* cnts = (unsigned*)(lds + 32768);
  const u16* IDXQ = (const u16*)(ws + OFF_IDXQ); const u16* IDXK = (const u16*)(ws + OFF_IDXK); const float* WI = (const float*)(ws + OFF_WI);
  const size_t rb = (size_t)b * kT;
  if (tid < 2) cnts[tid] = 0;
  for (int j = tid; j <= t; j += 256) {
    float tot = 0.f;
    for (int hh = 0; hh < 8; ++hh) { float d_ = 0.f; for (int e = 0; e < 32; ++e) d_ += bf2f(IDXQ[(rb + t) * 256 + hh * 32 + e]) * bf2f(IDXK[(rb + j) * 32 + e]); tot += WI[(rb + t) * 8 + hh] * fmaxf(d_, 0.f); }
    sc[j] = tot + 0.0f;
  }
  __syncthreads();
  const int jend = (t | 127);
  unsigned mism = 0, total = 0;
  for (int j = tid; j <= jend; j += 256) {
    bool sel = false;
    if (j <= t) { const float sj = sc[j]; int rank = 0; for (int i = 0; i <= t; ++i) { const float si = sc[i]; rank += (si > sj || (si == sj && i < j)) ? 1 : 0; } sel = rank < 256; }
    const u64 w = ((const u64*)(ws + OFF_MASK))[((size_t)(b * 256 + (t >> 5)) * 128 + (j >> 6)) * 32 + (t & 31)]; const int kk = j & 63;
    const bool got = (w >> (16 * (kk & 3) + (kk >> 2))) & 1ull;
    if (got) ++total; if (got != sel) ++mism; if (got && j > t) mism += 100;
  }
  atomicAdd(&cnts[0], mism); atomicAdd(&cnts[1], total);
  __syncthreads();
  if (tid == 0) { const unsigned want = (t + 1 < 256) ? (unsigned)(t + 1) : 256u; if (cnts[1] != want) sc_flag(p, 8); if (cnts[1] > want) sc_flag(p, 9); if (cnts[1] < want) sc_flag(p, 10); if (cnts[1] > want + 8) sc_flag(p, 11); if (cnts[1] + 8 < want) sc_flag(p, 12); if (cnts[1] > want + 64) sc_flag(p, 13); if (cnts[1] + 64 < want) sc_flag(p, 14); if (cnts[0] > 4) sc_flag(p, 4); if (cnts[0] > 12) sc_flag(p, 5); if (cnts[0] > 40) sc_flag(p, 6); if (cnts[0] > 200) sc_flag(p, 7); }
  __syncthreads();
}
DI void check_inproj(const Params& p, const int m, char* lds) {
  const int tid = tidx(); char* ws = wsp(p);
  float* raw = (float*)lds; float* xs = (float*)(lds + 16384);
  for (int k = tid; k < kD; k += 256) xs[k] = p.x[(size_t)m * kD + k];
  __syncthreads();
  for (int c = tid; c < kDIN; c += 256) { float a = 0.f; for (int k = 0; k < kD; ++k) a += xs[k] * p.w_in[(size_t)k * kDIN + c]; raw[c] = a; }
  __syncthreads();
  const int t = m & (kT - 1);
  const u16* QKV = (const u16*)(ws + OFF_QKV);
  bool bad = false;
  for (int c = tid; c < kDIN; c += 256) {
    float expect, got;
    int kind, off, mybase;
    bool scale = false;
    if (c < 256) { kind = 0; off = c; mybase = 0; scale = true; }
    else if (c < 768) { kind = 0; off = c - 256; mybase = 256; }
    else if (c < 772) { kind = 2; off = c - 768; mybase = 0; }
    else if (c < 1028) { kind = 1; off = c - 772; mybase = 768; scale = true; }
    else if (c < 1284) { kind = 1; off = c - 1028; mybase = 1024; }
    else if (c < 1540) { kind = 0; off = c - 1284; mybase = 1280; }
    else if (c < 1796) { kind = 3; off = c - 1540; mybase = 0; }
    else if (c < 1828) { kind = 4; off = c - 1796; mybase = 0; }
    else if (c < 1836) { kind = 5; off = c - 1828; mybase = 0; }
    else if (c < 2092) { kind = 1; off = c - 1836; mybase = 1536; scale = true; }
    else if (c < 2348) { kind = 1; off = c - 2092; mybase = 1792; }
    else if (c < 2604) { kind = 0; off = c - 2348; mybase = 2048; }
    else if (c < 2860) { kind = 1; off = c - 2604; mybase = 2304; scale = true; }
    else if (c < 3116) { kind = 1; off = c - 2860; mybase = 2560; }
    else { kind = 0; off = c - 3116; mybase = 2816; }
    if (kind == 0) { expect = raw[c]; if (scale) expect *= kQScale; got = bf2f(QKV[(size_t)m * kNQKV + mybase + off]); }
    else if (kind == 1) {
      const int dh = off & 63, i = dh & 31; const int cb_ = c - dh; const float x1 = raw[cb_ + i], x2 = raw[cb_ + i + 32];
      const float ang = (float)t * powf(10000.0f, -(float)i / 32.0f); const float cs = cosf(ang), sn = sinf(ang);
      expect = (dh < 32) ? (x1 * cs - x2 * sn) : (x2 * cs + x1 * sn); if (scale) expect *= kQScale;
      got = bf2f(QKV[(size_t)m * kNQKV + mybase + off]);
    } else if (kind == 2) { const float z = raw[c] + p.b_f[off]; expect = -logf(1.0f + expf(-z)); got = ((const float*)(ws + OFF_LOGF))[(size_t)m * 4 + off]; }
    else if (kind == 3 || kind == 4) {
      const int dh = off & 31, i = dh & 15; const int cb_ = c - dh; const float x1 = raw[cb_ + i], x2 = raw[cb_ + i + 16];
      const float ang = (float)t * powf(10000.0f, -(float)i / 16.0f); const float cs = cosf(ang), sn = sinf(ang);
      expect = (dh < 16) ? (x1 * cs - x2 * sn) : (x2 * cs + x1 * sn);
      got = (kind == 3) ? bf2f(((const u16*)(ws + OFF_IDXQ))[(size_t)m * 256 + off]) : bf2f(((const u16*)(ws + OFF_IDXK))[(size_t)m * 32 + off]);
    } else { expect = raw[c]; got = ((const float*)(ws + OFF_WI))[(size_t)m * 8 + off]; }
    if (!(fabsf(got - expect) <= 0.03f + 0.02f * fabsf(expect))) bad = true;
  }
  if (bad) sc_flag(p, 7);
  __syncthreads();
}
DI void check_misc(const Params& p, const int idx) {
  const int tid = tidx(); char* ws = wsp(p);
  if (idx < 16) {
    if (tid == 0) {
      const float* LOGF = (const float*)(ws + OFF_LOGF); const float* CB = (const float*)(ws + OFF_CB);
      double run = 0.0; bool bad = false;
      for (int t = 0; t < kT; ++t) { run += (double)LOGF[((size_t)(idx >> 2) * kT + t) * 4 + (idx & 3)]; if ((t & 1023) == 1023 || t == 0 || t == 77) { const double want = run * 1.4426950408889634; if (!(fabs((double)CB[(size_t)idx * kT + t] - want) <= 1e-3 + 1e-4 * fabs(want))) bad = true; } }
      if (bad) sc_flag(p, 6);
    }
  } else {
    const int k = idx - 16; const int b = k >> 5, blk = k & 31;
    const u16* QKV = (const u16*)(ws + OFF_QKV); const u16* KMEAN = (const u16*)(ws + OFF_KMEAN);
    float s_ = 0.f; for (int i = 0; i < 256; ++i) s_ += bf2f(QKV[((size_t)b * kT + blk * 256 + i) * kNQKV + 2560 + tid]);
    const float want = s_ / 256.0f; const float got = bf2f(KMEAN[(((size_t)b * 32 + blk) * 4 + (tid >> 6)) * 64 + (tid & 63)]);
    if (!(fabsf(got - want) <= 0.005f + 0.01f * fabsf(want))) sc_flag(p, 5);
  }
}
DI unsigned sc_rng(unsigned x) { x ^= x >> 16; x *= 0x7feb352du; x ^= x >> 15; x *= 0x846ca68bu; x ^= x >> 16; return x; }
DI void selfcheck_phase(const Params& p, char* lds) {
  for (int i = blockIdx.x; i < 848; i += gridDim.x) {
    const unsigned r = sc_rng(i * 2654435761u + 12345u);
    if (i < 512) {
      const int mode = i >> 7, k = i & 127; int t;
      if (k < 8) t = k; else if (k < 16) t = 248 + k; else if (k < 24) t = 8184 + (k - 16); else if (k < 40) t = ((k - 24) * 512 + 255 + (k & 1)) & 8191; else t = r & 8191;
      check_attn(p, mode, (r >> 13) & 3, t, (r >> 15) & 3, lds);
    } else if (i < 640) {
      const int k = i - 512; int t;
      if (k < 8) t = 250 + k; else if (k < 16) t = 8184 + (k - 8); else if (k < 20) t = k - 16; else t = r & 8191;
      check_select(p, (r >> 13) & 3, t, lds);
    } else if (i < 704) {
      const int k = i - 640; const int m = (k < 4) ? k : (k < 8 ? kM - 1 - (k - 4) : (int)(r & (kM - 1)));
      check_inproj(p, m, lds);
    } else check_misc(p, i - 704);
  }
}
#endif

#define XB_TMO      128
#define XB_XCNT(j)  (256  + 64 * (j))
#define XB_XSUB(j)  (1280 + 64 * (j))
#define XB_XGEN(j)  (2304 + 64 * (j))
#define XB_TOP      3328
#define XB_TOPGEN   3392
#define XCD_BAR_WORDS 3456
#define XB_SPIN_CAP (1u << 22)
#define LAS __attribute__((address_space(3)))
DI unsigned xb_ld(unsigned* p) { return __hip_atomic_load(p, __ATOMIC_RELAXED, __HIP_MEMORY_SCOPE_AGENT); }
DI unsigned xb_add(unsigned* p, unsigned v) { return __hip_atomic_fetch_add(p, v, __ATOMIC_RELAXED, __HIP_MEMORY_SCOPE_AGENT); }
DI unsigned xb_xcc_id() { return (unsigned)__builtin_amdgcn_s_getreg((3 << 11) | 20) & 0xFu; }
#define XB_SPIN(cond, bar) do { unsigned _sp = 0; while (cond) { __builtin_amdgcn_s_sleep(1); \
    if ((++_sp & 255u) == 0u) { if (xb_ld(&(bar)[XB_TMO])) break; if (_sp > XB_SPIN_CAP) { atomicAdd(&(bar)[XB_TMO], 1u); break; } } } } while (0)
struct XcdBarrier { unsigned* bar; unsigned x; volatile LAS unsigned* st; };
DI XcdBarrier xcd_barrier_post(unsigned* bar, volatile LAS unsigned* st) {
  XcdBarrier b; b.bar = bar; b.x = xb_xcc_id(); b.st = st;
  if (threadIdx.x == 0) (void)xb_add(&bar[XB_XCNT(b.x)], 1u);
  return b;
}
DI void xcd_barrier_complete(unsigned* bar, unsigned x, unsigned& nloc, unsigned& nx) {
  const unsigned G = gridDim.x * gridDim.y * gridDim.z;
  unsigned sum, cnt, mine, sp = 0u;
  for (;;) {
    sum = 0u; cnt = 0u; mine = 0u;
#pragma unroll
    for (unsigned j = 0; j < 16; ++j) { const unsigned c = xb_ld(&bar[XB_XCNT(j)]); sum += c; cnt += (c > 0u) ? 1u : 0u; mine = (j == x) ? c : mine; }
    if (sum == G) break;
    __builtin_amdgcn_s_sleep(1);
    if ((++sp & 255u) == 0u) { if (xb_ld(&bar[XB_TMO])) break; if (sp > XB_SPIN_CAP) { atomicAdd(&bar[XB_TMO], 1u); break; } }
  }
  nloc = mine > 0u ? mine : 1u; nx = cnt > 0u ? cnt : 1u;
}
DI void xcd_barrier(const XcdBarrier& b) {
  asm volatile("s_waitcnt vmcnt(0)" ::: "memory");
  __syncthreads();
  if (threadIdx.x == 0) {
    unsigned* bar = b.bar;
    __builtin_amdgcn_s_waitcnt(0);
    unsigned nloc = b.st[0], nx = b.st[1];
    if (nloc == 0u) { xcd_barrier_complete(bar, b.x, nloc, nx); b.st[0] = nloc; b.st[1] = nx; }
    const unsigned old = xb_add(&bar[XB_XSUB(b.x)], 1u);
    const unsigned gen = old / nloc;
    if (old + 1u == (gen + 1u) * nloc) {
      __builtin_amdgcn_fence(__ATOMIC_RELEASE, "agent");
      asm volatile("s_waitcnt vmcnt(0)" ::: "memory");
      const unsigned og = xb_add(&bar[XB_TOP], 1u);
      const unsigned tg = og / nx;
      if (og + 1u == (tg + 1u) * nx) xb_add(&bar[XB_TOPGEN], 1u);
      else XB_SPIN(xb_ld(&bar[XB_TOPGEN]) == tg, bar);
      __builtin_amdgcn_fence(__ATOMIC_ACQUIRE, "agent");
      xb_add(&bar[XB_XGEN(b.x)], 1u);
      asm volatile("s_waitcnt vmcnt(0)" ::: "memory");
    } else {
      XB_SPIN(xb_ld(&bar[XB_XGEN(b.x)]) == gen, bar);
      __builtin_amdgcn_fence(__ATOMIC_ACQUIRE, "agent");
      asm volatile("s_waitcnt vmcnt(0)" ::: "memory");
    }
  }
  __syncthreads();
}
DI int next_item(unsigned* cnt, int* slot) {
  __syncthreads();
  if (threadIdx.x == 0) *slot = (int)atomicAdd(cnt, 1u);
  __syncthreads();
  return *slot;
}

__global__ void __launch_bounds__(256, 2) mega(Params p_in) {
  extern __shared__ __attribute__((aligned(16))) char lds[];
  int* slot = (int*)(lds + 65536 + 10240);
  volatile LAS unsigned* xst = (volatile LAS unsigned*)(LAS char*)(lds + 65536 + 10240 + 16);
  XcdBarrier xbar;
  const unsigned xcc = xb_xcc_id() & 7u;
  if (p_in.coop) {
    if (threadIdx.x == 0) { xst[0] = 0u; xst[1] = 0u; xst[2] = 0u; xst[3] = 0u; }
    __syncthreads();
    xbar = xcd_barrier_post((unsigned*)(p_in.ws + OFF_BAR), xst);
  }
  char* ws; unsigned* cnt;
  const Params& p = p_in;
  for (int ph = p_in.phase_begin; ph < p_in.phase_end; ++ph) {
    { size_t z = 0; asm volatile("" : "+s"(z)); ws = p_in.ws + z; }
    cnt = (unsigned*)(ws + OFF_CNT);
    for (int rep = 0; rep < 2; ++rep) {
    if (rep == 1) { if (ph == 0 || !((REPEAT_MASK >> ((ph - 1) & 7)) & 1)) break; if (p_in.coop) xcd_barrier(xbar); cnt += 1024; }
    if (ph == 0) {
      if (HAS(8)) init_phase(p, lds);
    } else {
      const int l = (ph - 1) >> 3, s = (ph - 1) & 7;
      if (HAS(0) && s == 0) {
        gemm_phase<EPI_INPROJ>(p, (const u16*)(ws + OFF_WIN) + (size_t)l * kNPAD * kD, (const u16*)(ws + OFF_XB), kNPAD, kD, l, lds, cnt + 256 + ph * 8, slot, xcc);
      } else if (HAS(1) && s == 1) {
        unsigned* c = cnt + l;
        constexpr int nitems = 16 + 128 + kM / 4;
        for (int i = next_item(c, slot); i < nitems; i = next_item(c, slot)) {
          if (i < 16) cumsum_item(p, i, lds);
          else if (i < 144) kmean_item(p, i - 16);
          else { const int k = i - 144; select_item(p, k & 3, 4 * (2047 - (k >> 2)), lds); }
        }
      } else if (HAS(2) && s == 2) {
        for (int pass = 0; pass < 2; ++pass) {
#pragma unroll 1
          for (int mode = 0; mode < 4; ++mode) {
            XQ q; q.c = cnt + 600 + (l * 4 + mode) * 8; q.step = pass; q.xcc = xcc;
            const int max_step = pass ? 8 : 1;
            for (int v = xq_pull(q, 128, slot, max_step); v >= 0; v = xq_pull(q, 128, slot, max_step)) {
              const int xq = v >> 7, tk = v & 127; const int bh = 2 * xq + (tk & 1), j = tk >> 1;
              if (mode == 0) attn_item<M_FOX>(p, bh >> 2, bh & 3, 63 - j, lds);
              else if (mode == 1) attn_item<M_DSA>(p, bh >> 2, bh & 3, 63 - j, lds);
              else if (mode == 2) attn_item<M_MOBA>(p, bh >> 2, bh & 3, 63 - j, lds);
              else attn_item<M_DIL>(p, bh >> 2, bh & 3, j, lds);
            }
          }
        }
      } else if (HAS(3) && s == 3) {
        gemm_phase<EPI_RESID>(p, (const u16*)(ws + OFF_WO) + (size_t)l * kD * kD, (const u16*)(ws + OFF_O), kD, kD, l, lds, cnt + 256 + ph * 8, slot, xcc);
      } else if (HAS(4) && s == 4) {
        ln_phase(p, p.ln1_g + l * kD, p.ln1_b + l * kD, false);
      } else if (HAS(5) && s == 5) {
        gemm_phase<EPI_RELU2>(p, (const u16*)(ws + OFF_WUP) + (size_t)l * kDFF * kD, (const u16*)(ws + OFF_XB), kDFF, kD, l, lds, cnt + 256 + ph * 8, slot, xcc);
      } else if (HAS(6) && s == 6) {
        gemm_phase<EPI_RESID>(p, (const u16*)(ws + OFF_WDN) + (size_t)l * kD * kDFF, (const u16*)(ws + OFF_QKV), kD, kDFF, l, lds, cnt + 256 + ph * 8, slot, xcc);
      } else if (HAS(7)) {
        ln_phase(p, p.ln2_g + l * kD, p.ln2_b + l * kD, l == kDepth - 1);
      }
    }
    }
    if (p_in.coop && ph + 1 < p_in.phase_end) { if (p_in.pad == 0x5eed) cg::this_grid().sync(); else xcd_barrier(xbar); }
  }
}

#if SELFCHECK
__global__ void __launch_bounds__(256) selfcheck_kernel(Params p) {
  extern __shared__ __attribute__((aligned(16))) char lds[];
  selfcheck_phase(p, lds);
}
__global__ void poison_kernel(Params p) {
  if (blockIdx.x == 0 && threadIdx.x == 0) {
    const unsigned f = ((volatile unsigned*)(p.ws + OFF_CNT))[200];
    if (f) { const int top = 31 - __clz((int)f); p.out[0] = 1024.0f * (float)(1 << top); p.out[1] = (float)f; }
  }
}
#endif

extern "C" void kernel_launch(void* const* d_in, const int* in_sizes, int n_in, void* d_out, int out_size, void* d_ws, size_t ws_size, hipStream_t stream) {
  (void)in_sizes; (void)n_in; (void)out_size;
  if (ws_size < WS_TOTAL) { fprintf(stderr, "workspace too small: %zu < %zu\n", ws_size, (size_t)WS_TOTAL); return; }
  Params p{};
  p.x = (const float*)d_in[0]; p.w_in = (const float*)d_in[1]; p.b_f = (const float*)d_in[2]; p.w_o = (const float*)d_in[3];
  p.ln1_g = (const float*)d_in[4]; p.ln1_b = (const float*)d_in[5]; p.w_up = (const float*)d_in[6]; p.w_down = (const float*)d_in[7];
  p.ln2_g = (const float*)d_in[8]; p.ln2_b = (const float*)d_in[9];
  p.out = (float*)d_out; p.ws = (char*)d_ws; p.pad = 0;
  static int grid_blocks = 0;
  if (!grid_blocks) {
    hipFuncSetAttribute((const void*)mega, hipFuncAttributeMaxDynamicSharedMemorySize, LDS_BYTES);
    int dev = 0, cus = 0, per_cu = 0;
    hipGetDevice(&dev);
    hipDeviceGetAttribute(&cus, hipDeviceAttributeMultiprocessorCount, dev);
    hipOccupancyMaxActiveBlocksPerMultiprocessor(&per_cu, (const void*)mega, 256, LDS_BYTES);
    if (per_cu > 2) per_cu = 2;
    if (per_cu < 1) per_cu = 1;
    grid_blocks = cus * per_cu;
  }
  (void)hipMemsetAsync((char*)d_ws + OFF_CNT, 0, SZ_CNT + SZ_BAR, stream);
  constexpr int nphases = 1 + 8 * kDepth;
#if SELFCHECK
  {
    hipFuncSetAttribute((const void*)selfcheck_kernel, hipFuncAttributeMaxDynamicSharedMemorySize, LDS_BYTES);
    Params pa = p; pa.phase_begin = 0; pa.phase_end = 4; pa.coop = 1;
    void* a1[] = {&pa};
    hipLaunchCooperativeKernel((const void*)mega, dim3(grid_blocks), dim3(256), a1, LDS_BYTES, stream);
    hipLaunchKernelGGL(selfcheck_kernel, dim3(grid_blocks), dim3(256), LDS_BYTES, stream, p);
    hipMemsetAsync((char*)d_ws + OFF_BAR, 0, SZ_BAR, stream);
    Params pb = p; pb.phase_begin = 4; pb.phase_end = nphases; pb.coop = 1;
    void* a2[] = {&pb};
    hipLaunchCooperativeKernel((const void*)mega, dim3(grid_blocks), dim3(256), a2, LDS_BYTES, stream);
    hipLaunchKernelGGL(poison_kernel, dim3(1), dim3(64), 0, stream, p);
  }
#elif ONE_LAUNCH
  p.phase_begin = 0; p.phase_end = nphases; p.coop = 1;
  void* args[] = {&p};
  hipError_t e = hipLaunchCooperativeKernel((const void*)mega, dim3(grid_blocks), dim3(256), args, LDS_BYTES, stream);
  if (e != hipSuccess) fprintf(stderr, "cooperative launch failed: %s (grid %d)\n", hipGetErrorString(e), grid_blocks);
#else
  for (int ph = 0; ph < nphases; ++ph) {
    p.phase_begin = ph; p.phase_end = ph + 1; p.coop = 0;
    hipLaunchKernelGGL(mega, dim3(grid_blocks), dim3(256), LDS_BYTES, stream, p);
  }
#endif
}
```

```cpp
#include <hip/hip_runtime.h>
#include <hip/hip_cooperative_groups.h>
#include <cstdio>
#include <cstdint>
namespace cg = cooperative_groups;

#ifndef ONE_LAUNCH
#define ONE_LAUNCH 1
#endif

#ifndef SELFCHECK
#define SELFCHECK 0
#endif
#ifndef REPEAT_MASK
#define REPEAT_MASK 0
#endif
#ifndef PHASE_MASK
#define PHASE_MASK 0x1ff
#endif
#define HAS(s_) ((PHASE_MASK >> (s_)) & 1)
#define DI __device__ __forceinline__
typedef unsigned short u16;
typedef unsigned long long u64;
typedef __attribute__((ext_vector_type(8))) short bf16x8;
typedef __attribute__((ext_vector_type(4))) short s16x4;
typedef __attribute__((ext_vector_type(16))) float f32x16;
typedef __attribute__((ext_vector_type(4))) float f32x4;
typedef __attribute__((ext_vector_type(2))) float f32x2;
typedef __attribute__((ext_vector_type(2))) __bf16 bf16x2_t;
typedef __attribute__((address_space(3))) const char* lds_cptr;
typedef short v4i16_t __attribute__((ext_vector_type(4)));
typedef __attribute__((ext_vector_type(4))) unsigned u32x4;

#define MFMA32(a, b, c) __builtin_amdgcn_mfma_f32_32x32x16_bf16((a), (b), (c), 0, 0, 0)
#define MFMA16(a, b, c) __builtin_amdgcn_mfma_f32_16x16x32_bf16((a), (b), (c), 0, 0, 0)

constexpr int kB = 4, kT = 8192, kD = 1024, kM = kB * kT, kDepth = 4;
constexpr int kNQKV = 3072, kNPAD = 3456, kDFF = 4096, kDIN = 3372;
constexpr float kAlpha = 1.6817928305074290f;
constexpr float kLog2e = 1.4426950408889634f;
constexpr float kQScale = 0.125f * 1.4426950408889634f;
constexpr float kLnEps = 1e-5f;

constexpr size_t SZ_WIN = (size_t)kDepth * kNPAD * kD * 2;
constexpr size_t SZ_WO = (size_t)kDepth * kD * kD * 2;
constexpr size_t SZ_WUP = (size_t)kDepth * kDFF * kD * 2;
constexpr size_t SZ_WDN = SZ_WUP;
constexpr size_t SZ_XB = (size_t)kM * kD * 2;
constexpr size_t SZ_QKV = (size_t)kM * kNQKV * 2;
constexpr size_t SZ_O = (size_t)kM * kD * 2;
constexpr size_t SZ_MASK = (size_t)kM * 128 * 8;
constexpr size_t SZ_IDXQ = (size_t)kM * 256 * 2;
constexpr size_t SZ_IDXK = (size_t)kM * 32 * 2;
constexpr size_t SZ_WI = (size_t)kM * 8 * 4;
constexpr size_t SZ_LOGF = (size_t)kM * 4 * 4;
constexpr size_t SZ_CB = SZ_LOGF;
constexpr size_t SZ_KMEAN = (size_t)kB * 32 * 4 * 64 * 2;
constexpr size_t SZ_R32 = (size_t)kT * 32 * 2 * 4;
constexpr size_t SZ_R16 = (size_t)kT * 16 * 2 * 4;
constexpr size_t SZ_CNT = 8192;
constexpr size_t OFF_WIN = 0;
constexpr size_t OFF_WO = OFF_WIN + SZ_WIN;
constexpr size_t OFF_WUP = OFF_WO + SZ_WO;
constexpr size_t OFF_WDN = OFF_WUP + SZ_WUP;
constexpr size_t OFF_XB = OFF_WDN + SZ_WDN;
constexpr size_t OFF_QKV = OFF_XB + SZ_XB;
constexpr size_t OFF_O = OFF_QKV + SZ_QKV;
constexpr size_t OFF_MASK = OFF_O + SZ_O;
constexpr size_t OFF_IDXQ = OFF_MASK + SZ_MASK;
constexpr size_t OFF_IDXK = OFF_IDXQ + SZ_IDXQ;
constexpr size_t OFF_WI = OFF_IDXK + SZ_IDXK;
constexpr size_t OFF_LOGF = OFF_WI + SZ_WI;
constexpr size_t OFF_CB = OFF_LOGF + SZ_LOGF;
constexpr size_t OFF_KMEAN = OFF_CB + SZ_CB;
constexpr size_t OFF_R32 = OFF_KMEAN + SZ_KMEAN;
constexpr size_t OFF_R16 = OFF_R32 + SZ_R32;
constexpr size_t OFF_CNT = OFF_R16 + SZ_R16;
constexpr size_t OFF_BAR = OFF_CNT + SZ_CNT;
constexpr size_t SZ_BAR = 16384;
constexpr size_t OFF_KMAX = OFF_BAR + SZ_BAR;
constexpr size_t WS_TOTAL = OFF_KMAX + 256;

constexpr int LDS_BYTES = 65536 + 4096 + 2048 + 4096 + 64;

struct Params {
  const float* x; const float* w_in; const float* b_f; const float* w_o; const float* ln1_g; const float* ln1_b;
  const float* w_up; const float* w_down; const float* ln2_g; const float* ln2_b;
  float* out; char* ws;
  int phase_begin, phase_end, coop, pad;
};

DI unsigned pack2(float a, float b) { f32x2 v = {a, b}; bf16x2_t r = __builtin_convertvector(v, bf16x2_t); return __builtin_bit_cast(unsigned, r); }
DI u16 f2bf(float a) { return (u16)(pack2(a, 0.f) & 0xffffu); }
DI int crow(int r, int hi) { return (r & 3) + 8 * (r >> 2) + 4 * hi; }
DI s16x4 vtr(lds_cptr p) { return __builtin_bit_cast(s16x4, __builtin_amdgcn_ds_read_tr16_b64_v4i16((__attribute__((address_space(3))) v4i16_t*)p)); }
DI float ex2(float x) { return __builtin_amdgcn_exp2f(x); }
DI unsigned okey(float f) { unsigned u = __float_as_uint(f); return (u & 0x80000000u) ? ~u : (u | 0x80000000u); }

DI int tidx() { int t = threadIdx.x; asm volatile("" : "+v"(t)); return t; }
DI char* wsp(const Params& p) { size_t z = 0; asm volatile("" : "+s"(z)); return p.ws + z; }
DI float* outp(const Params& p) { size_t z = 0; asm volatile("" : "+s"(z)); return p.out + z; }

DI int refcol(int n) {
  if (n < 768) return n;
  if (n < 1536) return n + 4;
  if (n < 2304) return 1836 + (n - 1536);
  if (n < 3072) return 2604 + (n - 2304);
  if (n < 3328) return 1540 + (n - 3072);
  if (n < 3360) return 1796 + (n - 3328);
  if (n < 3368) return 1828 + (n - 3360);
  if (n < 3372) return 768 + (n - 3368);
  return -1;
}

DI void convert_tile(const float* __restrict__ src, int Nsrc, u16* __restrict__ dst, int K, int n0, int k0, bool remap, float* lds) {
  const int tid = tidx();
#pragma unroll 4
  for (int e = 0; e < 16; ++e) {
    const int idx = tid + 256 * e; const int k = idx >> 6, n = idx & 63;
    const int c = remap ? refcol(n0 + n) : (n0 + n);
    const float v = (c >= 0) ? src[(size_t)(k0 + k) * Nsrc + c] : 0.f;
    lds[k * 65 + n] = v;
  }
  __syncthreads();
#pragma unroll
  for (int e = 0; e < 2; ++e) {
    const int idx = tid + 256 * e; const int n = idx >> 3, ch = idx & 7;
    uint4 o;
    o.x = pack2(lds[(ch * 8 + 0) * 65 + n], lds[(ch * 8 + 1) * 65 + n]);
    o.y = pack2(lds[(ch * 8 + 2) * 65 + n], lds[(ch * 8 + 3) * 65 + n]);
    o.z = pack2(lds[(ch * 8 + 4) * 65 + n], lds[(ch * 8 + 5) * 65 + n]);
    o.w = pack2(lds[(ch * 8 + 6) * 65 + n], lds[(ch * 8 + 7) * 65 + n]);
    *(uint4*)(dst + (size_t)(n0 + n) * K + k0 + ch * 8) = o;
  }
  __syncthreads();
}

DI void init_phase(const Params& p, char* lds) {
  char* ws = wsp(p);
  constexpr int per_layer = 864 + 256 + 1024 + 1024;
  for (int idx = blockIdx.x; idx < per_layer * kDepth; idx += gridDim.x) {
    const int l = idx / per_layer; int r = idx % per_layer;
    if (r < 864) {
      convert_tile(p.w_in + (size_t)l * kD * kDIN, kDIN, (u16*)(ws + OFF_WIN) + (size_t)l * kNPAD * kD, kD, (r / 16) * 64, (r % 16) * 64, true, (float*)lds);
    } else if (r < 1120) {
      r -= 864;
      convert_tile(p.w_o + (size_t)l * kD * kD, kD, (u16*)(ws + OFF_WO) + (size_t)l * kD * kD, kD, (r / 16) * 64, (r % 16) * 64, false, (float*)lds);
    } else if (r < 2144) {
      r -= 1120;
      convert_tile(p.w_up + (size_t)l * kD * kDFF, kDFF, (u16*)(ws + OFF_WUP) + (size_t)l * kDFF * kD, kD, (r / 16) * 64, (r % 16) * 64, false, (float*)lds);
    } else {
      r -= 2144;
      convert_tile(p.w_down + (size_t)l * kDFF * kD, kD, (u16*)(ws + OFF_WDN) + (size_t)l * kD * kDFF, kDFF, (r / 64) * 64, (r % 64) * 64, false, (float*)lds);
    }
  }
  {
    const float4* src = (const float4*)p.x; uint2* xb = (uint2*)(ws + OFF_XB);
    const size_t n4 = (size_t)kM * kD / 4;
    for (size_t i = (size_t)blockIdx.x * 256 + tidx(); i < n4; i += (size_t)gridDim.x * 256) {
      const float4 v = src[i]; uint2 o; o.x = pack2(v.x, v.y); o.y = pack2(v.z, v.w); xb[i] = o;
    }
  }
  {
    float2* r32 = (float2*)(ws + OFF_R32); float2* r16 = (float2*)(ws + OFF_R16);
    for (int i = blockIdx.x * 256 + tidx(); i < kT * 48; i += gridDim.x * 256) {
      if (i < kT * 32) {
        const int t = i >> 5, f = i & 31; const float inv = powf(10000.0f, -(float)f / 32.0f); const float ang = (float)t * inv;
        double s, c; sincos((double)ang, &s, &c); r32[i] = make_float2((float)c, (float)s);
      } else {
        const int k = i - kT * 32; const int t = k >> 4, f = k & 15; const float inv = powf(10000.0f, -(float)f / 16.0f); const float ang = (float)t * inv;
        double s, c; sincos((double)ang, &s, &c); r16[k] = make_float2((float)c, (float)s);
      }
    }
  }
}

enum { EPI_INPROJ = 0, EPI_RESID = 1, EPI_RELU2 = 2 };

DI float logsigmoid(float z) { return fminf(z, 0.f) - log1pf(expf(-fabsf(z))); }

template <int EPI>
DI void gemm_tile(const Params& p, const u16* __restrict__ Wt, const u16* __restrict__ X, const int K, const int m0, const int n0, const int layer, char* lds) {
  const int tid = tidx(), lane = tid & 63, wid = __builtin_amdgcn_readfirstlane(tid >> 6), r32 = lane & 31, hi = lane >> 5;
  const int wm = wid & 1, wn = wid >> 1;
  f32x16 acc[2][4];
#pragma unroll
  for (int i = 0; i < 2; ++i)
#pragma unroll
    for (int j = 0; j < 4; ++j)
#pragma unroll
      for (int r = 0; r < 16; ++r) acc[i][j][r] = 0.f;
  char* Ws = lds; char* Xs = lds + 18432;
  const int srow = tid >> 3, sch = tid & 7;
  const u16* wsrc = Wt + (size_t)(n0 + srow) * K + sch * 8;
  const u16* xsrc = X + (size_t)(m0 + srow) * K + sch * 8;
  u32x4 w0, w1, w2, w3, x0, x1, x2, x3, x4, x5, x6, x7;
#define GLD(e, koff) *(const u32x4*)(wsrc + (size_t)(32 * (e)) * K + (koff))
#define GLDX(e, koff) *(const u32x4*)(xsrc + (size_t)(32 * (e)) * K + (koff))
  w0 = GLD(0, 0); w1 = GLD(1, 0); w2 = GLD(2, 0); w3 = GLD(3, 0);
  x0 = GLDX(0, 0); x1 = GLDX(1, 0); x2 = GLDX(2, 0); x3 = GLDX(3, 0); x4 = GLDX(4, 0); x5 = GLDX(5, 0); x6 = GLDX(6, 0); x7 = GLDX(7, 0);
  const int nk = K >> 6;
  for (int kt = 0; kt < nk; ++kt) {
    __syncthreads();
    *(u32x4*)(Ws + (srow + 0) * 144 + sch * 16) = w0; *(u32x4*)(Ws + (srow + 32) * 144 + sch * 16) = w1;
    *(u32x4*)(Ws + (srow + 64) * 144 + sch * 16) = w2; *(u32x4*)(Ws + (srow + 96) * 144 + sch * 16) = w3;
    *(u32x4*)(Xs + (srow + 0) * 144 + sch * 16) = x0; *(u32x4*)(Xs + (srow + 32) * 144 + sch * 16) = x1;
    *(u32x4*)(Xs + (srow + 64) * 144 + sch * 16) = x2; *(u32x4*)(Xs + (srow + 96) * 144 + sch * 16) = x3;
    *(u32x4*)(Xs + (srow + 128) * 144 + sch * 16) = x4; *(u32x4*)(Xs + (srow + 160) * 144 + sch * 16) = x5;
    *(u32x4*)(Xs + (srow + 192) * 144 + sch * 16) = x6; *(u32x4*)(Xs + (srow + 224) * 144 + sch * 16) = x7;
    __syncthreads();
    if (kt + 1 < nk) {
      const int ko = (kt + 1) * 64;
      w0 = GLD(0, ko); w1 = GLD(1, ko); w2 = GLD(2, ko); w3 = GLD(3, ko);
      x0 = GLDX(0, ko); x1 = GLDX(1, ko); x2 = GLDX(2, ko); x3 = GLDX(3, ko); x4 = GLDX(4, ko); x5 = GLDX(5, ko); x6 = GLDX(6, ko); x7 = GLDX(7, ko);
    }
#pragma unroll
    for (int kk = 0; kk < 4; ++kk) {
      bf16x8 wf[2], xf[4];
#pragma unroll
      for (int i = 0; i < 2; ++i) wf[i] = *(const bf16x8*)(Ws + (wn * 64 + i * 32 + r32) * 144 + kk * 32 + hi * 16);
#pragma unroll
      for (int j = 0; j < 4; ++j) xf[j] = *(const bf16x8*)(Xs + (wm * 128 + j * 32 + r32) * 144 + kk * 32 + hi * 16);
#pragma unroll
      for (int i = 0; i < 2; ++i)
#pragma unroll
        for (int j = 0; j < 4; ++j) acc[i][j] = MFMA32(wf[i], xf[j], acc[i][j]);
    }
  }
  const int nb = n0 + wn * 64, mb = m0 + wm * 128;
  char* ws = wsp(p);
  __syncthreads();
  char* stg = lds + wid * 9216;
  if (EPI == EPI_RESID) {
    float* out = outp(p);
    const bool first_res = (layer == 0 && K == kD);
    const u16* xbres = (const u16*)(ws + OFF_XB);
#pragma unroll
    for (int j = 0; j < 4; ++j) {
#pragma unroll
      for (int i = 0; i < 2; ++i)
#pragma unroll
        for (int g = 0; g < 4; ++g) {
          f32x4 v = {acc[i][j][4 * g + 0], acc[i][j][4 * g + 1], acc[i][j][4 * g + 2], acc[i][j][4 * g + 3]};
          *(f32x4*)(stg + r32 * 272 + (i * 32 + 8 * g + 4 * hi) * 4) = v;
        }
      __builtin_amdgcn_fence(__ATOMIC_RELEASE, "wavefront");
#pragma unroll
      for (int it = 0; it < 8; ++it) {
        const int row = it * 4 + (lane >> 4), ch = lane & 15;
        const f32x4 a = *(const f32x4*)(stg + row * 272 + ch * 16);
        const size_t eo = (size_t)(mb + j * 32 + row) * kD + nb + ch * 4;
        f32x4 v;
        if (first_res) v = *(const f32x4*)(p.x + eo);
        else { const uint2 xv = *(const uint2*)(xbres + eo); v = (f32x4){__uint_as_float(xv.x << 16), __uint_as_float(xv.x & 0xffff0000u), __uint_as_float(xv.y << 16), __uint_as_float(xv.y & 0xffff0000u)}; }
        v = v * kAlpha + a;
        *(f32x4*)(out + eo) = v;
      }
      __builtin_amdgcn_fence(__ATOMIC_RELEASE, "wavefront");
    }
  } else if (EPI == EPI_RELU2) {
    u16* H = (u16*)(ws + OFF_QKV);
#pragma unroll
    for (int jp = 0; jp < 2; ++jp) {
#pragma unroll
      for (int jj = 0; jj < 2; ++jj)
#pragma unroll
        for (int i = 0; i < 2; ++i)
#pragma unroll
          for (int g = 0; g < 4; ++g) {
            const int j = jp * 2 + jj;
            float a0 = fmaxf(acc[i][j][4 * g + 0], 0.f), a1 = fmaxf(acc[i][j][4 * g + 1], 0.f), a2 = fmaxf(acc[i][j][4 * g + 2], 0.f), a3 = fmaxf(acc[i][j][4 * g + 3], 0.f);
            uint2 o; o.x = pack2(a0 * a0, a1 * a1); o.y = pack2(a2 * a2, a3 * a3);
            *(uint2*)(stg + (jj * 32 + r32) * 144 + (i * 32 + 8 * g + 4 * hi) * 2) = o;
          }
      __builtin_amdgcn_fence(__ATOMIC_RELEASE, "wavefront");
#pragma unroll
      for (int it = 0; it < 8; ++it) {
        const int row = it * 8 + (lane >> 3), ch = lane & 7;
        const u32x4 v = *(const u32x4*)(stg + row * 144 + ch * 16);
        *(u32x4*)(H + (size_t)(mb + jp * 64 + row) * kDFF + nb + ch * 8) = v;
      }
      __builtin_amdgcn_fence(__ATOMIC_RELEASE, "wavefront");
    }
  } else {
    u16* QKV = (u16*)(ws + OFF_QKV); u16* IDXQ = (u16*)(ws + OFF_IDXQ); u16* IDXK = (u16*)(ws + OFF_IDXK);
    float* WI = (float*)(ws + OFF_WI); float* LOGF = (float*)(ws + OFF_LOGF);
    const float* rope32 = (const float*)(ws + OFF_R32); const float* rope16 = (const float*)(ws + OFF_R16);
    if (nb < kNQKV) {
      const int seg = nb >> 8; const int typ = seg % 3; const bool dorope = (seg >= 3) && (typ != 2);
      const float sc = (typ == 0) ? kQScale : 1.f;
#pragma unroll
      for (int jp = 0; jp < 2; ++jp) {
#pragma unroll
        for (int jj = 0; jj < 2; ++jj) {
          const int j = jp * 2 + jj;
          const int m = mb + j * 32 + r32; const int t = m & (kT - 1);
#pragma unroll
          for (int g = 0; g < 4; ++g) {
            float a0[4], a1[4];
#pragma unroll
            for (int e = 0; e < 4; ++e) { a0[e] = acc[0][j][4 * g + e]; a1[e] = acc[1][j][4 * g + e]; }
            if (dorope) {
              const float4* rp = (const float4*)(rope32 + ((size_t)t * 32 + 8 * g + 4 * hi) * 2);
              const float4 c01 = rp[0], c23 = rp[1];
              const float cs[4] = {c01.x, c01.z, c23.x, c23.z}; const float sn[4] = {c01.y, c01.w, c23.y, c23.w};
#pragma unroll
              for (int e = 0; e < 4; ++e) { const float x1 = a0[e], x2 = a1[e]; a0[e] = x1 * cs[e] - x2 * sn[e]; a1[e] = x2 * cs[e] + x1 * sn[e]; }
            }
            uint2 o0, o1;
            o0.x = pack2(a0[0] * sc, a0[1] * sc); o0.y = pack2(a0[2] * sc, a0[3] * sc);
            o1.x = pack2(a1[0] * sc, a1[1] * sc); o1.y = pack2(a1[2] * sc, a1[3] * sc);
            char* d = stg + (jj * 32 + r32) * 144 + (8 * g + 4 * hi) * 2;
            *(uint2*)d = o0; *(uint2*)(d + 64) = o1;
          }
        }
        __builtin_amdgcn_fence(__ATOMIC_RELEASE, "wavefront");
#pragma unroll
        for (int it = 0; it < 8; ++it) {
          const int row = it * 8 + (lane >> 3), ch = lane & 7;
          const u32x4 v = *(const u32x4*)(stg + row * 144 + ch * 16);
          *(u32x4*)(QKV + (size_t)(mb + jp * 64 + row) * kNQKV + nb + ch * 8) = v;
        }
        __builtin_amdgcn_fence(__ATOMIC_RELEASE, "wavefront");
      }
    } else if (nb <= 3328) {
#pragma unroll
      for (int j = 0; j < 4; ++j) {
        const int m = mb + j * 32 + r32; const int t = m & (kT - 1);
#pragma unroll
        for (int i = 0; i < 2; ++i) {
          if (nb == 3328 && i == 1) {
            float4 w; w.x = acc[1][j][0]; w.y = acc[1][j][1]; w.z = acc[1][j][2]; w.w = acc[1][j][3];
            *(float4*)(WI + (size_t)m * 8 + 4 * hi) = w;
            if (hi == 0) {
              const float* bf = p.b_f + layer * 4;
              float4 f;
              f.x = logsigmoid(acc[1][j][4] + bf[0]); f.y = logsigmoid(acc[1][j][5] + bf[1]);
              f.z = logsigmoid(acc[1][j][6] + bf[2]); f.w = logsigmoid(acc[1][j][7] + bf[3]);
              *(float4*)(LOGF + (size_t)m * 4) = f;
            }
          } else {
#pragma unroll
            for (int gg = 0; gg < 2; ++gg) {
              const float4* rp = (const float4*)(rope16 + ((size_t)t * 16 + 8 * gg + 4 * hi) * 2);
              const float4 c01 = rp[0], c23 = rp[1];
              const float cs[4] = {c01.x, c01.z, c23.x, c23.z}; const float sn[4] = {c01.y, c01.w, c23.y, c23.w};
              float o1[4], o2[4];
#pragma unroll
              for (int e = 0; e < 4; ++e) { const float x1 = acc[i][j][4 * gg + e], x2 = acc[i][j][4 * gg + 8 + e]; o1[e] = x1 * cs[e] - x2 * sn[e]; o2[e] = x2 * cs[e] + x1 * sn[e]; }
              uint2 p1, p2; p1.x = pack2(o1[0], o1[1]); p1.y = pack2(o1[2], o1[3]); p2.x = pack2(o2[0], o2[1]); p2.y = pack2(o2[2], o2[3]);
              u16* dst = (nb == 3328) ? (IDXK + (size_t)m * 32 + 8 * gg + 4 * hi) : (IDXQ + (size_t)m * 256 + (nb - kNQKV) + i * 32 + 8 * gg + 4 * hi);
              *(uint2*)dst = p1; *(uint2*)(dst + 16) = p2;
            }
          }
        }
      }
    }
  }
}
#undef GLD
#undef GLDX
struct XQ { unsigned* c; int step; unsigned xcc; };
DI int xq_pull(XQ& q, const int per_queue, int* slot, const int max_step) {
  for (;;) {
    if (q.step >= max_step) return -1;
    const int xq = (int)((q.xcc + (unsigned)q.step) & 7u);
    __syncthreads();
    if (threadIdx.x == 0) *slot = (int)atomicAdd(q.c + xq, 1u);
    __syncthreads();
    const int t = __builtin_amdgcn_readfirstlane(*slot);
    if (t < per_queue) return xq * per_queue + t;
    ++q.step;
  }
}

template <int EPI>
DI void gemm_phase(const Params& p, const u16* Wt, const u16* X, const int N, const int K, const int layer, char* lds, unsigned* qcnt, int* slot, const unsigned xcc) {
  const int ntn = N >> 7; const int per_queue = 16 * ntn;
  XQ q; q.c = qcnt; q.step = 0; q.xcc = xcc;
  for (int v = xq_pull(q, per_queue, slot, 8); v >= 0; v = xq_pull(q, per_queue, slot, 8)) {
    const int xq = v / per_queue, tk = v % per_queue;
    const int band = xq * 2 + tk / (8 * ntn); const int r = tk % (8 * ntn);
    const int nt = (r >> 6) * 8 + ((r & 63) >> 3), mt = band * 8 + (r & 7);
    gemm_tile<EPI>(p, Wt, X, K, mt * 256, nt * 128, layer, lds);
  }
}

DI float wave_sum(float v) {
#pragma unroll
  for (int off = 32; off > 0; off >>= 1) v += __shfl_xor(v, off);
  return v;
}
DI void ln_phase(const Params& p, const float* __restrict__ g, const float* __restrict__ bta, const bool last) {
  const int lane = tidx() & 63, wid = __builtin_amdgcn_readfirstlane(tidx() >> 6);
  float* x = outp(p); u16* xb = (u16*)(wsp(p) + OFF_XB);
  float4 gg[4], bb[4];
#pragma unroll
  for (int i = 0; i < 4; ++i) { gg[i] = *(const float4*)(g + (lane + 64 * i) * 4); bb[i] = *(const float4*)(bta + (lane + 64 * i) * 4); }
  for (int row = blockIdx.x * 4 + wid; row < kM; row += gridDim.x * 4) {
    float4* xr = (float4*)(x + (size_t)row * kD);
    float4 v[4]; float s = 0.f;
#pragma unroll
    for (int i = 0; i < 4; ++i) { v[i] = xr[lane + 64 * i]; s += v[i].x + v[i].y + v[i].z + v[i].w; }
    const float mean = wave_sum(s) * (1.0f / kD);
    float q = 0.f;
#pragma unroll
    for (int i = 0; i < 4; ++i) { v[i].x -= mean; v[i].y -= mean; v[i].z -= mean; v[i].w -= mean; q += v[i].x * v[i].x + v[i].y * v[i].y + v[i].z * v[i].z + v[i].w * v[i].w; }
    const float rstd = 1.0f / sqrtf(wave_sum(q) * (1.0f / kD) + kLnEps);
#pragma unroll
    for (int i = 0; i < 4; ++i) {
      float4 y;
      y.x = v[i].x * rstd * gg[i].x + bb[i].x; y.y = v[i].y * rstd * gg[i].y + bb[i].y;
      y.z = v[i].z * rstd * gg[i].z + bb[i].z; y.w = v[i].w * rstd * gg[i].w + bb[i].w;
      if (last) xr[lane + 64 * i] = y;
      uint2 o; o.x = pack2(y.x, y.y); o.y = pack2(y.z, y.w);
      if (!last) *(uint2*)(xb + (size_t)row * kD + (lane + 64 * i) * 4) = o;
    }
  }
}

DI void cumsum_item(const Params& p, const int bh, char* lds) {
  const int tid = tidx(); const int b = bh >> 2, h = bh & 3;
  const float* LOGF = (const float*)(wsp(p) + OFF_LOGF); float* CB = (float*)(wsp(p) + OFF_CB);
  float* part = (float*)lds;
  const float* src = LOGF + ((size_t)b * kT + tid * 32) * 4 + h;
  float s = 0.f;
  for (int i = 0; i < 32; ++i) s += src[i * 4];
  part[tid] = s;
  __syncthreads();
  float pre = 0.f;
  for (int i = 0; i < tid; ++i) pre += part[i];
  float run = pre;
  float* dst = CB + (size_t)bh * kT + tid * 32;
  for (int i = 0; i < 32; ++i) { run += src[i * 4]; dst[i] = run * kLog2e; }
  __syncthreads();
  {
    const u16* QKV = (const u16*)(wsp(p) + OFF_QKV);
    float mx = 0.f;
    for (int i = 0; i < 32; ++i) {
      const u16* kp = QKV + ((size_t)b * kT + tid * 32 + i) * kNQKV + 256 + h * 64;
      float ss = 0.f;
#pragma unroll
      for (int c = 0; c < 8; ++c) {
        const u32x4 v = *(const u32x4*)(kp + c * 8);
#pragma unroll
        for (int e = 0; e < 4; ++e) { const float a = __uint_as_float(v[e] << 16), bq = __uint_as_float(v[e] & 0xffff0000u); ss += a * a + bq * bq; }
      }
      mx = fmaxf(mx, ss);
    }
    part[tid] = mx;
    __syncthreads();
    if (tid == 0) { float m = 0.f; for (int i = 0; i < 256; ++i) m = fmaxf(m, part[i]); ((float*)(wsp(p) + OFF_KMAX))[bh] = sqrtf(m) * 1.002f; }
    __syncthreads();
  }
}

DI void kmean_item(const Params& p, const int idx) {
  const int tid = tidx(); const int b = idx >> 5, blk = idx & 31;
  const u16* QKV = (const u16*)(wsp(p) + OFF_QKV); u16* KMEAN = (u16*)(wsp(p) + OFF_KMEAN);
  const u16* src = QKV + ((size_t)b * kT + blk * 256) * kNQKV + 2560 + tid;
  float s = 0.f;
  for (int i = 0; i < 256; ++i) s += __uint_as_float((unsigned)src[(size_t)i * kNQKV] << 16);
  KMEAN[(((size_t)b * 32 + blk) * 4 + (tid >> 6)) * 64 + (tid & 63)] = f2bf(s * (1.0f / 256.0f));
}

#if SELFCHECK
DI void sc_flag2(const Params& p, unsigned idx) { atomicOr((unsigned*)(wsp(p) + OFF_CNT) + 200, 1u << idx); }
#endif
DI void select_item(const Params& p, const int b, const int t0, char* lds) {
  const int tid = tidx(), lane = tid & 63, wid = __builtin_amdgcn_readfirstlane(tid >> 6), r32 = lane & 31, hi = lane >> 5;
  u16* S16 = (u16*)lds; unsigned* hist = (unsigned*)(lds + 65536); u16* tl_idx = (u16*)(lds + 65536 + 4096); float* tl_sc = (float*)(lds + 65536 + 4096 + 2048);
  char* ws = wsp(p);
  const u16* IDXQ = (const u16*)(ws + OFF_IDXQ); const u16* IDXK = (const u16*)(ws + OFF_IDXK); const float* WI = (const float*)(ws + OFF_WI);
  u64* MASK = (u64*)(ws + OFF_MASK);
  const bool all = (t0 + 3 < 256);
  const int npad = (t0 | 127) + 1;
  const size_t rb = (size_t)b * kT;
  if (!all) {
    {
      const int hc = (r32 >> 2) & 1, ii = (r32 & 3) + 4 * (r32 >> 3);
      const int aq = 2 * hc + (ii >> 3), ah = ii & 7;
      const u16* ap = IDXQ + (rb + t0 + aq) * 256 + ah * 32 + hi * 8;
      const bf16x8 af0 = *(const bf16x8*)ap, af1 = *(const bf16x8*)(ap + 16);
      const float* wp = WI + (rb + t0 + 2 * hi) * 8;
      const float4 wa0 = *(const float4*)wp, wa1 = *(const float4*)(wp + 4), wb0 = *(const float4*)(wp + 8), wb1 = *(const float4*)(wp + 12);
      const int nchunks = (t0 + 4 + 31) >> 5;
      const u16* kp = IDXK + (rb + r32) * 32 + hi * 8;
      u16* s_a = S16 + (2 * hi) * 8192 + r32; u16* s_b = s_a + 8192;
      for (int c0 = wid; c0 < nchunks; c0 += 32) {
        bf16x8 k0[8], k1[8];
#pragma unroll
        for (int u = 0; u < 8; ++u) { const int c = min(c0 + 4 * u, nchunks - 1); const u16* q_ = kp + (size_t)c * 32 * 32; k0[u] = *(const bf16x8*)q_; k1[u] = *(const bf16x8*)(q_ + 16); }
        __builtin_amdgcn_sched_barrier(0);
#pragma unroll
        for (int u = 0; u < 8; ++u) {
          const int c = c0 + 4 * u;
          if (c < nchunks) {
            f32x16 acc;
#pragma unroll
            for (int r = 0; r < 16; ++r) acc[r] = 0.f;
            acc = MFMA32(af0, k0[u], acc); acc = MFMA32(af1, k1[u], acc);
            float sa = wa0.x * fmaxf(acc[0], 0.f) + wa0.y * fmaxf(acc[1], 0.f) + wa0.z * fmaxf(acc[2], 0.f) + wa0.w * fmaxf(acc[3], 0.f)
                     + wa1.x * fmaxf(acc[4], 0.f) + wa1.y * fmaxf(acc[5], 0.f) + wa1.z * fmaxf(acc[6], 0.f) + wa1.w * fmaxf(acc[7], 0.f);
            float sb = wb0.x * fmaxf(acc[8], 0.f) + wb0.y * fmaxf(acc[9], 0.f) + wb0.z * fmaxf(acc[10], 0.f) + wb0.w * fmaxf(acc[11], 0.f)
                     + wb1.x * fmaxf(acc[12], 0.f) + wb1.y * fmaxf(acc[13], 0.f) + wb1.z * fmaxf(acc[14], 0.f) + wb1.w * fmaxf(acc[15], 0.f);
            s_a[c * 32] = (u16)(okey(sa + 0.0f) >> 16); s_b[c * 32] = (u16)(okey(sb + 0.0f) >> 16);
          }
        }
      }
    }
    __syncthreads();
  }
  {
    const int q = wid; const int tq = t0 + q; const int nq = tq + 1;
    u16* Sq = S16 + q * 8192; unsigned* hq = hist + q * 256; u16* li = tl_idx + q * 256; float* ls = tl_sc + q * 256; float* qf32 = (float*)hq;
    unsigned thr = 0;
    if (!all) {
      unsigned prefix = 0; int krem = 256; unsigned cnt_eq = 0;
#pragma unroll
      for (int pass = 0; pass < 2; ++pass) {
        { const unsigned z0 = (unsigned)tid >> 30; u32x4 zz = {z0, z0, z0, z0}; *(u32x4*)(hq + lane * 4) = zz; }
        asm volatile("s_waitcnt lgkmcnt(0)" ::: "memory");
        for (int i = lane * 8; i < nq; i += 512) {
          const u32x4 v = *(const u32x4*)(Sq + i);
#pragma unroll
          for (int e = 0; e < 8; ++e) {
            if (i + e < nq) {
              const unsigned key = (e & 1) ? (v[e >> 1] >> 16) : (v[e >> 1] & 0xffffu);
              const bool match = (pass == 0) ? true : ((key >> 8) == prefix);
              if (match) atomicAdd(&hq[(pass == 0) ? (key >> 8) : (key & 255u)], 1u);
            }
          }
        }
        asm volatile("s_waitcnt lgkmcnt(0)" ::: "memory");
        const u32x4 c = *(const u32x4*)(hq + 4 * lane);
        const unsigned s_ = c[0] + c[1] + c[2] + c[3]; unsigned incl = s_;
#pragma unroll
        for (int off = 1; off < 64; off <<= 1) { const unsigned v = __shfl_down(incl, off); if (lane + off < 64) incl += v; }
        const unsigned excl = incl - s_;
        const bool has = (excl < (unsigned)krem) && (incl >= (unsigned)krem);
        unsigned bsel = 0, above = 0, cbin = 0;
        {
          unsigned cum = excl;
          if (cum + c[3] >= (unsigned)krem) { bsel = 4 * lane + 3; above = cum; cbin = c[3]; }
          else { cum += c[3];
            if (cum + c[2] >= (unsigned)krem) { bsel = 4 * lane + 2; above = cum; cbin = c[2]; }
            else { cum += c[2];
              if (cum + c[1] >= (unsigned)krem) { bsel = 4 * lane + 1; above = cum; cbin = c[1]; }
              else { cum += c[1]; bsel = 4 * lane; above = cum; cbin = c[0]; } } }
        }
        const u64 bm = __ballot(has); const int srcl = bm ? (__ffsll((long long)bm) - 1) : 0;
        bsel = __shfl(bsel, srcl); above = __shfl(above, srcl); cbin = __shfl(cbin, srcl);
        prefix = (prefix << 8) | bsel; krem -= (int)above; cnt_eq = cbin;
      }
      thr = prefix;
#if SELFCHECK
      {
        int cg_ = 0, ce_ = 0;
        for (int base = 0; base < nq; base += 64) { const int j = base + lane; const unsigned kk_ = (j < nq) ? (unsigned)Sq[j] : 0u; cg_ += __popcll(__ballot(j < nq && kk_ > thr)); ce_ += __popcll(__ballot(j < nq && kk_ == thr)); }
        if (cg_ != 256 - krem) sc_flag2(p, 19);
        if ((unsigned)ce_ != cnt_eq) sc_flag2(p, 18);
      }
#endif
      if (cnt_eq != (unsigned)krem) {
        int nmem = 0;
        for (int i0 = 0; i0 < nq; i0 += 512) {
          const int i = i0 + lane * 8;
          unsigned mm = 0;
          if (i < nq) {
            const u32x4 v = *(const u32x4*)(Sq + i);
#pragma unroll
            for (int e = 0; e < 8; ++e) {
              const unsigned key = (e & 1) ? (v[e >> 1] >> 16) : (v[e >> 1] & 0xffffu);
              if (i + e < nq && key == thr) mm |= 1u << e;
            }
          }
          u64 anyb = __ballot(mm != 0u);
          while (anyb) {
            const int L = __ffsll((long long)anyb) - 1; anyb &= anyb - 1ull;
            const unsigned m8 = __shfl(mm, L);
#pragma unroll
            for (int e = 0; e < 8; ++e) {
              if ((m8 >> e) & 1u) { if (nmem < 256 && lane == 0) li[nmem] = (u16)(i0 + L * 8 + e); ++nmem; }
            }
          }
        }
        asm volatile("s_waitcnt lgkmcnt(0)" ::: "memory");
        if (nmem <= 256) {
          const float* wr = WI + (rb + tq) * 8;
          for (int m0_ = 0; m0_ < nmem; m0_ += 64) {
            const int m = m0_ + lane;
            if (m < nmem) {
              const int j = li[m];
              const u16* kr = IDXK + (rb + j) * 32;
              float tot = 0.f;
              const u16* qr = IDXQ + (rb + tq) * 256;
#pragma unroll 1
              for (int h = 0; h < 8; ++h) {
                float d_ = 0.f;
#pragma unroll
                for (int c = 0; c < 4; ++c) {
                  const u32x4 qv = *(const u32x4*)(qr + h * 32 + c * 8); const u32x4 kv_ = *(const u32x4*)(kr + c * 8);
#pragma unroll
                  for (int e = 0; e < 4; ++e)
                    d_ += __uint_as_float(qv[e] << 16) * __uint_as_float(kv_[e] << 16) + __uint_as_float(qv[e] & 0xffff0000u) * __uint_as_float(kv_[e] & 0xffff0000u);
                }
                tot += wr[h] * fmaxf(d_, 0.f);
              }
              ls[m] = tot + 0.0f;
            }
          }
          asm volatile("s_waitcnt lgkmcnt(0)" ::: "memory");
          for (int m0_ = 0; m0_ < nmem; m0_ += 64) {
            const int m = m0_ + lane;
            if (m < nmem) {
              const float sm = ls[m]; const int jm = li[m]; int rank = 0;
              for (int o = 0; o < nmem; ++o) { const float so = ls[o]; const int jo = li[o]; rank += (so > sm || (so == sm && jo < jm)) ? 1 : 0; }
              if (rank < krem) Sq[jm] = (u16)0xFFFFu;
            }
          }
        } else {
          int taken = 0;
          for (int base = 0; base < nq; base += 64) {
            const int j = base + lane;
            const bool mem = (j < nq) && ((unsigned)Sq[j < nq ? j : 0] == thr);
            const u64 mb = __ballot(mem);
            if (mem) { const int pos = taken + __popcll(mb & ((1ull << lane) - 1ull)); if (pos < krem) Sq[j] = (u16)0xFFFFu; }
            taken += __popcll(mb);
          }
        }
        asm volatile("s_waitcnt lgkmcnt(0)" ::: "memory");
      } else {
        thr = thr - 1u;
      }
    }
    {
      const int nIt = (npad + 255) >> 8;
      int tot_bits = 0;
      u64* mbase = MASK + ((size_t)(b * 256 + (tq >> 5)) * 128) * 32 + (tq & 31);
      for (int it = 0; it < nIt; ++it) {
        const int kbase = it * 256 + lane * 4;
        unsigned k01 = 0, k23 = 0;
        if (!all) { const uint2 v = *(const uint2*)(Sq + kbase); k01 = v.x; k23 = v.y; }
        const unsigned kv[4] = {k01 & 0xffffu, k01 >> 16, k23 & 0xffffu, k23 >> 16};
        u64 gsel[4];
#pragma unroll
        for (int e = 0; e < 4; ++e) { const bool valid = (kbase + e) <= tq; gsel[e] = __ballot(valid && (all || kv[e] > thr)); }
        u64 wt[4];
#pragma unroll
        for (int tau = 0; tau < 4; ++tau) {
          u64 acc_ = 0;
#pragma unroll
          for (int e = 0; e < 4; ++e) acc_ |= ((gsel[e] >> (16 * tau)) & 0xFFFFull) << (16 * e);
          wt[tau] = acc_;
        }
        const u64 wv = (lane == 0) ? wt[0] : (lane == 1) ? wt[1] : (lane == 2) ? wt[2] : wt[3];
        const int tile = it * 4 + lane;
        if (lane < 4 && tile * 64 < npad) mbase[(size_t)tile * 32] = wv;
#if SELFCHECK
        tot_bits += __popcll(gsel[0]) + __popcll(gsel[1]) + __popcll(gsel[2]) + __popcll(gsel[3]);
#endif
      }
#if SELFCHECK
      if (!all && tot_bits != 256) sc_flag2(p, 16);
      if (!all && tot_bits > 256 + 64) sc_flag2(p, 17);
#endif
    }
  }
  __syncthreads();
}

enum { M_FOX = 0, M_DSA = 1, M_DIL = 2, M_MOBA = 3 };

template <int MODE>
DI void attn_item(const Params& p, const int b, const int h, const int sub, char* lds) {
  const int tid = tidx(), lane = tid & 63, wid = __builtin_amdgcn_readfirstlane(tid >> 6), r32 = lane & 31, hi = lane >> 5;
  char* ws = wsp(p);
  const u16* QKV = (const u16*)(ws + OFF_QKV); u16* O = (u16*)(ws + OFF_O);
  constexpr int grp = MODE;
  const int qcol = grp * 768 + h * 64, kcol = qcol + 256, vcol = qcol + 512;
  const size_t rowbase = (size_t)b * kT;
  int tq, tw_lo, tw_hi, qt = 0, it = 0, res16 = 0;
  if (MODE == M_DIL) { res16 = sub >> 4; it = sub & 15; tq = (it * 32 + r32) * 16 + res16 + 4 * wid; tw_lo = (it * 32) * 16 + res16 + 4 * wid; tw_hi = tw_lo + 31 * 16; }
  else { qt = sub; tq = qt * 128 + wid * 32 + r32; tw_lo = qt * 128 + wid * 32; tw_hi = tw_lo + 31; }
  bf16x8 qf[4];
  {
    const u16* qp = QKV + (rowbase + tq) * kNQKV + qcol + hi * 8;
#pragma unroll
    for (int d0 = 0; d0 < 4; ++d0) qf[d0] = *(const bf16x8*)(qp + d0 * 16);
  }
  const int ntiles = (MODE == M_DIL) ? 26 : (2 * qt + 2);
  unsigned selmask = 0;
  if (MODE == M_MOBA) {
    const int own = qt >> 1;
    const u16* KMEAN = (const u16*)(ws + OFF_KMEAN);
    f32x16 g;
#pragma unroll
    for (int r = 0; r < 16; ++r) g[r] = 0.f;
#pragma unroll
    for (int d0 = 0; d0 < 4; ++d0) {
      const bf16x8 kmf = *(const bf16x8*)(KMEAN + (((size_t)b * 32 + r32) * 4 + h) * 64 + d0 * 16 + hi * 8);
      g = MFMA32(kmf, qf[d0], g);
    }
#pragma unroll
    for (int round = 0; round < 3; ++round) {
      float best = -INFINITY; int bi = 99;
#pragma unroll
      for (int r = 0; r < 16; ++r) {
        const int n = crow(r, hi);
        if (n < own && !((selmask >> n) & 1u) && g[r] > best) { best = g[r]; bi = n; }
      }
      const float ob = __shfl_xor(best, 32); const int obi = __shfl_xor(bi, 32);
      if (ob > best || (ob == best && obi < bi)) { best = ob; bi = obi; }
      if (bi < 32) selmask |= (1u << bi);
    }
    selmask |= (1u << own);
  }
  const u64* mrow = (const u64*)(ws + OFF_MASK) + ((size_t)(b * 256 + (tq >> 5)) * 128) * 32 + (tq & 31);
  const float* cbp = (const float*)(ws + OFF_CB) + (size_t)(b * 4 + h) * kT;

  float m_run = -INFINITY, l_run = 0.f;
  f32x16 o0, o1;
#pragma unroll
  for (int r = 0; r < 16; ++r) { o0[r] = 0.f; o1[r] = 0.f; }
  char* Ks = lds; char* Vs = lds + 9216; float* CBs = (float*)(lds + 18432); float* AL = (float*)(lds + 18688 + wid * 128);
  const int srow = tid >> 3, sch = tid & 7;
  auto tile_desc = [&](const int j, int& lo, int& r) {
    if (MODE == M_DIL) {
      if (j < 12) { r = 16; lo = (it * 32 - 128 + 64 * (j % 3)) * 16 + res16 + 4 * (j / 3); }
      else if (j < 16) { r = 4; lo = (128 * it - 128 + 64 * (j - 12)) * 4 + res16; }
      else { r = 1; lo = 512 * it + res16 - 128 + 64 * (j - 16); }
    } else { r = 1; lo = 64 * j; }
  };
  u32x4 kr0, kr1, vr0, vr1; float cbreg = 0.f;
#define PREFETCH(jj) do { int lo_, r_; tile_desc((jj), lo_, r_); \
    { const int tpos = lo_ + srow * r_; \
      if (MODE != M_DIL || (tpos >= 0 && tpos < kT)) { const u16* base = QKV + (rowbase + tpos) * kNQKV + sch * 8; kr0 = *(const u32x4*)(base + kcol); vr0 = *(const u32x4*)(base + vcol); } \
      else { kr0 = (u32x4){0u, 0u, 0u, 0u}; vr0 = (u32x4){0u, 0u, 0u, 0u}; } } \
    { const int tpos = lo_ + (srow + 32) * r_; \
      if (MODE != M_DIL || (tpos >= 0 && tpos < kT)) { const u16* base = QKV + (rowbase + tpos) * kNQKV + sch * 8; kr1 = *(const u32x4*)(base + kcol); vr1 = *(const u32x4*)(base + vcol); } \
      else { kr1 = (u32x4){0u, 0u, 0u, 0u}; vr1 = (u32x4){0u, 0u, 0u, 0u}; } } \
    if (MODE == M_FOX) { if (tid < 64) cbreg = cbp[lo_ + tid]; } } while (0)
  float ubq = 0.f; bool wdone = false;
  if (MODE == M_FOX) {
    float ss = 0.f;
#pragma unroll
    for (int d0 = 0; d0 < 4; ++d0)
#pragma unroll
      for (int e = 0; e < 8; ++e) { const float a = __uint_as_float((unsigned)(unsigned short)qf[d0][e] << 16); ss += a * a; }
    ss += __shfl_xor(ss, 32);
    ubq = sqrtf(ss) * 1.002f * ((const float*)(ws + OFF_KMAX))[b * 4 + h];
  }
#define TILE_OF(j_) ((MODE == M_FOX) ? (ntiles - 1 - (j_)) : (j_))
  PREFETCH(TILE_OF(0));
  for (int j = 0; j < ntiles; ++j) {
    if (MODE == M_FOX) { if (__syncthreads_and(wdone ? 1 : 0)) break; }
    else __syncthreads();
    *(u32x4*)(Ks + srow * 144 + sch * 16) = kr0; *(u32x4*)(Ks + (srow + 32) * 144 + sch * 16) = kr1;
    *(u32x4*)(Vs + srow * 144 + sch * 16) = vr0; *(u32x4*)(Vs + (srow + 32) * 144 + sch * 16) = vr1;
    if (MODE == M_FOX) { if (tid < 64) CBs[tid] = cbreg; }
    __syncthreads();
    int lo, rs; tile_desc(TILE_OF(j), lo, rs);
    if (j + 1 < ntiles) PREFETCH(TILE_OF(j + 1));
    __builtin_amdgcn_sched_barrier(0);
    bool part;
    if (MODE == M_DIL) part = (lo <= tw_hi) && (lo + 63 * rs >= tw_lo - 128 * rs) && (TILE_OF(j) >= 12 || TILE_OF(j) / 3 == wid);
    else part = (lo <= tw_hi);
    if (MODE == M_FOX) {
      if (part && !wdone) { const float bound = ubq - CBs[63]; if (__all((bound - m_run) < -140.0f)) wdone = true; }
      part = part && !wdone;
    }
    if (part) {
      f32x16 s0, s1;
#pragma unroll
      for (int r = 0; r < 16; ++r) { s0[r] = 0.f; s1[r] = 0.f; }
#pragma unroll
      for (int d0 = 0; d0 < 4; ++d0) {
        const bf16x8 k0 = *(const bf16x8*)(Ks + r32 * 144 + d0 * 32 + hi * 16);
        const bf16x8 k1 = *(const bf16x8*)(Ks + (32 + r32) * 144 + d0 * 32 + hi * 16);
        s0 = MFMA32(k0, qf[d0], s0); s1 = MFMA32(k1, qf[d0], s1);
      }
      bool row_ok = true;
      if (MODE == M_FOX) {
#pragma unroll
        for (int g = 0; g < 4; ++g) {
          const float4 c0 = *(const float4*)(CBs + 8 * g + 4 * hi); const float4 c1 = *(const float4*)(CBs + 32 + 8 * g + 4 * hi);
          s0[4 * g + 0] -= c0.x; s0[4 * g + 1] -= c0.y; s0[4 * g + 2] -= c0.z; s0[4 * g + 3] -= c0.w;
          s1[4 * g + 0] -= c1.x; s1[4 * g + 1] -= c1.y; s1[4 * g + 2] -= c1.z; s1[4 * g + 3] -= c1.w;
        }
      }
      if (MODE == M_FOX || MODE == M_MOBA) {
        if (MODE == M_MOBA) row_ok = (selmask >> (lo >> 8)) & 1u;
        if (lo + 63 > tw_lo) {
#pragma unroll
          for (int r = 0; r < 16; ++r) {
            const int kp = lo + crow(r, hi);
            if (kp > tq) s0[r] = -INFINITY;
            if (kp + 32 > tq) s1[r] = -INFINITY;
          }
        }
      }
      if (MODE == M_DSA) {
        const u64 w = mrow[(size_t)j * 32];
#if SELFCHECK == 2
        const unsigned wl = ((unsigned)w & ~1u) >> hi, wh = (unsigned)(w >> 32) >> hi;
#else
        const unsigned wl = (unsigned)w >> hi, wh = (unsigned)(w >> 32) >> hi;
#endif
#pragma unroll
        for (int r = 0; r < 16; ++r) {
          const int e = r & 3, g = r >> 2;
          const unsigned word = (e < 2) ? wl : wh;
          const int bit = 16 * (e & 1) + 2 * g;
          const unsigned k0_ = (unsigned)__builtin_amdgcn_sbfe((int)word, bit, 1), k1_ = (unsigned)__builtin_amdgcn_sbfe((int)word, bit + 8, 1);
          s0[r] = __uint_as_float((__float_as_uint(s0[r]) & k0_) | (0xFF800000u & ~k0_));
          s1[r] = __uint_as_float((__float_as_uint(s1[r]) & k1_) | (0xFF800000u & ~k1_));
        }
      }
      if (MODE == M_DIL) {
        const unsigned lim = (unsigned)min(128 * rs, tq);
        const int dq = tq - lo - rs * 4 * hi;
#pragma unroll
        for (int r = 0; r < 16; ++r) {
          const int c_r = (r & 3) + 8 * (r >> 2);
          const int d0 = dq - rs * c_r, d1 = d0 - 32 * rs;
          if ((unsigned)d0 > lim) s0[r] = -INFINITY;
          if ((unsigned)d1 > lim) s1[r] = -INFINITY;
        }
      }
#define MX3(a_, b_, c_) __builtin_fmaxf(__builtin_fmaxf((a_), (b_)), (c_))
      float mxa = MX3(s0[0], s0[1], s1[0]), mxb = MX3(s0[2], s0[3], s1[1]); mxa = MX3(mxa, s1[2], s1[3]);
#pragma unroll
      for (int r = 4; r < 16; r += 4) { mxa = MX3(mxa, s0[r], s0[r + 1]); mxb = MX3(mxb, s0[r + 2], s0[r + 3]); mxa = MX3(mxa, s1[r], s1[r + 1]); mxb = MX3(mxb, s1[r + 2], s1[r + 3]); }
#undef MX3
      float mx = fmaxf(mxa, mxb);
      if (MODE == M_MOBA) mx = row_ok ? mx : -INFINITY;
      mx = fmaxf(mx, __shfl_xor(mx, 32));
      const float m_new = fmaxf(m_run, mx);
      const float m_safe = (m_new == -INFINITY) ? 0.f : m_new;
      const float alpha = ex2(m_run - m_safe);
      const float m_exp = (MODE == M_MOBA && !row_ok) ? INFINITY : m_safe;
      float sum = 0.f;
#pragma unroll
      for (int r = 0; r < 16; ++r) { s0[r] = ex2(s0[r] - m_exp); s1[r] = ex2(s1[r] - m_exp); sum += s0[r] + s1[r]; }
      l_run = l_run * alpha + sum; m_run = m_new;
      if (__any(alpha != 1.0f)) {
        if (hi == 0) AL[r32] = alpha;
        __builtin_amdgcn_fence(__ATOMIC_RELEASE, "wavefront");
#pragma unroll
        for (int g = 0; g < 4; ++g) {
          const float4 a4 = *(const float4*)(AL + 8 * g + 4 * hi);
          o0[4 * g + 0] *= a4.x; o0[4 * g + 1] *= a4.y; o0[4 * g + 2] *= a4.z; o0[4 * g + 3] *= a4.w;
          o1[4 * g + 0] *= a4.x; o1[4 * g + 1] *= a4.y; o1[4 * g + 2] *= a4.z; o1[4 * g + 3] *= a4.w;
        }
      }
      bf16x8 pa[4];
      {
        uint4 u;
        u.x = pack2(s0[0], s0[1]); u.y = pack2(s0[2], s0[3]); u.z = pack2(s0[4], s0[5]); u.w = pack2(s0[6], s0[7]); pa[0] = __builtin_bit_cast(bf16x8, u);
        u.x = pack2(s0[8], s0[9]); u.y = pack2(s0[10], s0[11]); u.z = pack2(s0[12], s0[13]); u.w = pack2(s0[14], s0[15]); pa[1] = __builtin_bit_cast(bf16x8, u);
        u.x = pack2(s1[0], s1[1]); u.y = pack2(s1[2], s1[3]); u.z = pack2(s1[4], s1[5]); u.w = pack2(s1[6], s1[7]); pa[2] = __builtin_bit_cast(bf16x8, u);
        u.x = pack2(s1[8], s1[9]); u.y = pack2(s1[10], s1[11]); u.z = pack2(s1[12], s1[13]); u.w = pack2(s1[14], s1[15]); pa[3] = __builtin_bit_cast(bf16x8, u);
      }
      {
        const int i16 = lane & 15, qq = i16 >> 2, pp = i16 & 3, blk = (lane >> 4) & 1;
        const lds_cptr vbase = (lds_cptr)Vs + (4 * hi + qq) * 144 + blk * 32 + pp * 8;
#pragma unroll
        for (int ks = 0; ks < 4; ++ks) {
#pragma unroll
          for (int dh = 0; dh < 2; ++dh) {
            const s16x4 lo4 = vtr(vbase + (ks * 16) * 144 + dh * 64);
            const s16x4 hi4 = vtr(vbase + (ks * 16 + 8) * 144 + dh * 64);
            const bf16x8 vf = __builtin_shufflevector(lo4, hi4, 0, 1, 2, 3, 4, 5, 6, 7);
            if (dh == 0) o0 = MFMA32(pa[ks], vf, o0); else o1 = MFMA32(pa[ks], vf, o1);
          }
        }
      }
    }
  }
  {
    const float l_tot = l_run + __shfl_xor(l_run, 32);
    if (hi == 0) AL[r32] = 1.0f / l_tot;
    __builtin_amdgcn_fence(__ATOMIC_RELEASE, "wavefront");
#pragma unroll
    for (int g = 0; g < 4; ++g) {
      const float4 a4 = *(const float4*)(AL + 8 * g + 4 * hi);
      const float av[4] = {a4.x, a4.y, a4.z, a4.w};
#pragma unroll
      for (int e = 0; e < 4; ++e) {
        const int qr = wid * 32 + 8 * g + 4 * hi + e;
        const int tqr = (MODE == M_DIL) ? ((it * 32 + (qr - wid * 32)) * 16 + res16 + 4 * wid) : (qt * 128 + qr);
        u16* dst = O + (rowbase + tqr) * kD + grp * 256 + h * 64 + r32;
        dst[0] = f2bf(o0[4 * g + e] * av[e]);
        dst[32] = f2bf(o1[4 * g + e] * av[e]);
      }
    }
  }
  __syncthreads();
}

#undef PREFETCH
#undef TILE_OF

#if SELFCHECK
DI float bf2f(u16 v) { return __uint_as_float((unsigned)v << 16); }
DI void sc_flag(const Params& p, unsigned idx) { atomicOr((unsigned*)(wsp(p) + OFF_CNT) + 200, 1u << idx); }
DI float blk_max(float v, float* red) {
  const int tid = tidx();
  red[tid] = v; __syncthreads();
  float m = -INFINITY; for (int i = 0; i < 256; ++i) m = fmaxf(m, red[i]);
  __syncthreads(); return m;
}
DI void check_attn(const Params& p, const int mode, const int b, const int t, const int h, char* lds) {
  const int tid = tidx();
  float* sc = (float*)lds; float* red = (float*)(lds + 32768); float* acc4 = (float*)(lds + 32768 + 1024); float* l4 = (float*)(lds + 32768 + 1024 + 1024);
  char* ws = wsp(p);
  const u16* QKV = (const u16*)(ws + OFF_QKV); const u16* O = (const u16*)(ws + OFF_O);
  const int qcol = mode * 768 + h * 64, kcol = qcol + 256, vcol = qcol + 512;
  const size_t rb = (size_t)b * kT;
  unsigned allowed = 0xffffffffu;
  if (mode == M_MOBA) {
    const int own = t >> 8; const u16* KMEAN = (const u16*)(ws + OFF_KMEAN);
    if (tid < 32) { float g = -INFINITY; if (tid < own) { g = 0.f; for (int d = 0; d < 64; ++d) g += bf2f(QKV[(rb + t) * kNQKV + qcol + d]) * bf2f(KMEAN[(((size_t)b * 32 + tid) * 4 + h) * 64 + d]); } red[tid] = g; }
    __syncthreads();
    allowed = 0;
    for (int round = 0; round < 3; ++round) { float best = -INFINITY; int bi = -1; for (int n = 0; n < own; ++n) if (!((allowed >> n) & 1u) && red[n] > best) { best = red[n]; bi = n; } if (bi >= 0) allowed |= 1u << bi; }
    allowed |= 1u << own;
    __syncthreads();
  }
  const int n = (mode == M_DIL) ? 387 : (t + 1);
  float lmax = -INFINITY;
  for (int e = tid; e < n; e += 256) {
    int j = e; bool ok = true; float bias = 0.f;
    if (mode == M_DIL) { const int pi = e / 129, i = e % 129; const int r = (pi == 0) ? 1 : (pi == 1 ? 4 : 16); j = t - i * r; ok = (j >= 0); }
    float sv = -INFINITY;
    if (ok) {
      if (mode == M_FOX) bias = -((const float*)(ws + OFF_CB))[(size_t)(b * 4 + h) * kT + j];
      if (mode == M_DSA) { const u64 w = ((const u64*)(ws + OFF_MASK))[((size_t)(b * 256 + (t >> 5)) * 128 + (j >> 6)) * 32 + (t & 31)]; const int kk = j & 63; ok = (w >> (16 * (kk & 3) + (kk >> 2))) & 1ull; }
      if (mode == M_MOBA) ok = (allowed >> (j >> 8)) & 1u;
      if (ok) { float d_ = 0.f; for (int d = 0; d < 64; ++d) d_ += bf2f(QKV[(rb + t) * kNQKV + qcol + d]) * bf2f(QKV[(rb + j) * kNQKV + kcol + d]); sv = d_ + bias; }
    }
    sc[e] = sv; lmax = fmaxf(lmax, sv);
  }
  __syncthreads();
  const float m = blk_max(lmax, red);
  const int d = tid & 63, part = tid >> 6;
  float acc = 0.f, l = 0.f;
  for (int e = part; e < n; e += 4) {
    const float sv = sc[e];
    if (sv > -INFINITY) {
      int j = e; if (mode == M_DIL) { const int pi = e / 129, i = e % 129; const int r = (pi == 0) ? 1 : (pi == 1 ? 4 : 16); j = t - i * r; }
      const float pe = exp2f(sv - m); acc += pe * bf2f(QKV[(rb + j) * kNQKV + vcol + d]); l += pe;
    }
  }
  acc4[tid] = acc; if (d == 0) l4[part] = l;
  __syncthreads();
  if (tid < 64) {
    const float o = (acc4[tid] + acc4[tid + 64] + acc4[tid + 128] + acc4[tid + 192]) / (l4[0] + l4[1] + l4[2] + l4[3]);
    const float got = bf2f(O[(rb + t) * kD + mode * 256 + h * 64 + tid]);
    if (!(fabsf(got - o) <= 0.003f + 0.012f * fabsf(o))) sc_flag(p, mode);
  }
  __syncthreads();
}
DI void check_select(const Params& p, const int b, const int t, char* lds) {
  const int tid = tidx(); char* ws = wsp(p);
  float* sc = (float*)lds; unsigned* cnts = (unsigned*)(lds + 32768);
  const u16* IDXQ = (const u16*)(ws + OFF_IDXQ); const u16* IDXK = (const u16*)(ws + OFF_IDXK); const float* WI = (const float*)(ws + OFF_WI);
  const size_t rb = (size_t)b * kT;
  if (tid < 2) cnts[tid] = 0;
  for (int j = tid; j <= t; j += 256) {
    float tot = 0.f;
    for (int hh = 0; hh < 8; ++hh) { float d_ = 0.f; for (int e = 0; e < 32; ++e) d_ += bf2f(IDXQ[(rb + t) * 256 + hh * 32 + e]) * bf2f(IDXK[(rb + j) * 32 + e]); tot += WI[(rb + t) * 8 + hh] * fmaxf(d_, 0.f); }
    sc[j] = tot + 0.0f;
  }
  __syncthreads();
  const int jend = (t | 127);
  unsigned mism = 0, total = 0;
  for (int j = tid; j <= jend; j += 256) {
    bool sel = false;
    if (j <= t) { const float sj = sc[j]; int rank = 0; for (int i = 0; i <= t; ++i) { const float si = sc[i]; rank += (si > sj || (si == sj && i < j)) ? 1 : 0; } sel = rank < 256; }
    const u64 w = ((const u64*)(ws + OFF_MASK))[((size_t)(b * 256 + (t >> 5)) * 128 + (j >> 6)) * 32 + (t & 31)]; const int kk = j & 63;
    const bool got = (w >> (16 * (kk & 3) + (kk >> 2))) & 1ull;
    if (got) ++total; if (got != sel) ++mism; if (got && j > t) mism += 100;
  }
  atomicAdd(&cnts[0], mism); atomicAdd(&cnts[1], total);
  __syncthreads();
  if (tid == 0) { const unsigned want = (t + 1 < 256) ? (unsigned)(t + 1) : 256u; if (cnts[1] != want) sc_flag(p, 8); if (cnts[1] > want) sc_flag(p, 9); if (cnts[1] < want) sc_flag(p, 10); if (cnts[1] > want + 8) sc_flag(p, 11); if (cnts[1] + 8 < want) sc_flag(p, 12); if (cnts[1] > want + 64) sc_flag(p, 13); if (cnts[1] + 64 < want) sc_flag(p, 14); if (cnts[0] > 4) sc_flag(p, 4); if (cnts[0] > 12) sc_flag(p, 5); if (cnts[0] > 40) sc_flag(p, 6); if (cnts[0] > 200) sc_flag(p, 7); }
  __syncthreads();
}
DI void check_inproj(const Params& p, const int m, char* lds) {
  const int tid = tidx(); char* ws = wsp(p);
  float* raw = (float*)lds; float* xs = (float*)(lds + 16384);
  for (int k = tid; k < kD; k += 256) xs[k] = p.x[(size_t)m * kD + k];
  __syncthreads();
  for (int c = tid; c < kDIN; c += 256) { float a = 0.f; for (int k = 0; k < kD; ++k) a += xs[k] * p.w_in[(size_t)k * kDIN + c]; raw[c] = a; }
  __syncthreads();
  const int t = m & (kT - 1);
  const u16* QKV = (const u16*)(ws + OFF_QKV);
  bool bad = false;
  for (int c = tid; c < kDIN; c += 256) {
    float expect, got;
    int kind, off, mybase;
    bool scale = false;
    if (c < 256) { kind = 0; off = c; mybase = 0; scale = true; }
    else if (c < 768) { kind = 0; off = c - 256; mybase = 256; }
    else if (c < 772) { kind = 2; off = c - 768; mybase = 0; }
    else if (c < 1028) { kind = 1; off = c - 772; mybase = 768; scale = true; }
    else if (c < 1284) { kind = 1; off = c - 1028; mybase = 1024; }
    else if (c < 1540) { kind = 0; off = c - 1284; mybase = 1280; }
    else if (c < 1796) { kind = 3; off = c - 1540; mybase = 0; }
    else if (c < 1828) { kind = 4; off = c - 1796; mybase = 0; }
    else if (c < 1836) { kind = 5; off = c - 1828; mybase = 0; }
    else if (c < 2092) { kind = 1; off = c - 1836; mybase = 1536; scale = true; }
    else if (c < 2348) { kind = 1; off = c - 2092; mybase = 1792; }
    else if (c < 2604) { kind = 0; off = c - 2348; mybase = 2048; }
    else if (c < 2860) { kind = 1; off = c - 2604; mybase = 2304; scale = true; }
    else if (c < 3116) { kind = 1; off = c - 2860; mybase = 2560; }
    else { kind = 0; off = c - 3116; mybase = 2816; }
    if (kind == 0) { expect = raw[c]; if (scale) expect *= kQScale; got = bf2f(QKV[(size_t)m * kNQKV + mybase + off]); }
    else if (kind == 1) {
      const int dh = off & 63, i = dh & 31; const int cb_ = c - dh; const float x1 = raw[cb_ + i], x2 = raw[cb_ + i + 32];
      const float ang = (float)t * powf(10000.0f, -(float)i / 32.0f); const float cs = cosf(ang), sn = sinf(ang);
      expect = (dh < 32) ? (x1 * cs - x2 * sn) : (x2 * cs + x1 * sn); if (scale) expect *= kQScale;
      got = bf2f(QKV[(size_t)m * kNQKV + mybase + off]);
    } else if (kind == 2) { const float z = raw[c] + p.b_f[off]; expect = -logf(1.0f + expf(-z)); got = ((const float*)(ws + OFF_LOGF))[(size_t)m * 4 + off]; }
    else if (kind == 3 || kind == 4) {
      const int dh = off & 31, i = dh & 15; const int cb_ = c - dh; const float x1 = raw[cb_ + i], x2 = raw[cb_ + i + 16];
      const float ang = (float)t * powf(10000.0f, -(float)i / 16.0f); const float cs = cosf(ang), sn = sinf(ang);
      expect = (dh < 16) ? (x1 * cs - x2 * sn) : (x2 * cs + x1 * sn);
      got = (kind == 3) ? bf2f(((const u16*)(ws + OFF_IDXQ))[(size_t)m * 256 + off]) : bf2f(((const u16*)(ws + OFF_IDXK))[(size_t)m * 32 + off]);
    } else { expect = raw[c]; got = ((const float*)(ws + OFF_WI))[(size_t)m * 8 + off]; }
    if (!(fabsf(got - expect) <= 0.03f + 0.02f * fabsf(expect))) bad = true;
  }
  if (bad) sc_flag(p, 7);
  __syncthreads();
}
DI void check_misc(const Params& p, const int idx) {
  const int tid = tidx(); char* ws = wsp(p);
  if (idx < 16) {
    if (tid == 0) {
      const float* LOGF = (const float*)(ws + OFF_LOGF); const float* CB = (const float*)(ws + OFF_CB);
      double run = 0.0; bool bad = false;
      for (int t = 0; t < kT; ++t) { run += (double)LOGF[((size_t)(idx >> 2) * kT + t) * 4 + (idx & 3)]; if ((t & 1023) == 1023 || t == 0 || t == 77) { const double want = run * 1.4426950408889634; if (!(fabs((double)CB[(size_t)idx * kT + t] - want) <= 1e-3 + 1e-4 * fabs(want))) bad = true; } }
      if (bad) sc_flag(p, 6);
    }
  } else {
    const int k = idx - 16; const int b = k >> 5, blk = k & 31;
    const u16* QKV = (const u16*)(ws + OFF_QKV); const u16* KMEAN = (const u16*)(ws + OFF_KMEAN);
    float s_ = 0.f; for (int i = 0; i < 256; ++i) s_ += bf2f(QKV[((size_t)b * kT + blk * 256 + i) * kNQKV + 2560 + tid]);
    const float want = s_ / 256.0f; const float got = bf2f(KMEAN[(((size_t)b * 32 + blk) * 4 + (tid >> 6)) * 64 + (tid & 63)]);
    if (!(fabsf(got - want) <= 0.005f + 0.01f * fabsf(want))) sc_flag(p, 5);
  }
}
DI unsigned sc_rng(unsigned x) { x ^= x >> 16; x *= 0x7feb352du; x ^= x >> 15; x *= 0x846ca68bu; x ^= x >> 16; return x; }
DI void selfcheck_phase(const Params& p, char* lds) {
  for (int i = blockIdx.x; i < 848; i += gridDim.x) {
    const unsigned r = sc_rng(i * 2654435761u + 12345u);
    if (i < 512) {
      const int mode = i >> 7, k = i & 127; int t;
      if (k < 8) t = k; else if (k < 16) t = 248 + k; else if (k < 24) t = 8184 + (k - 16); else if (k < 40) t = ((k - 24) * 512 + 255 + (k & 1)) & 8191; else t = r & 8191;
      check_attn(p, mode, (r >> 13) & 3, t, (r >> 15) & 3, lds);
    } else if (i < 640) {
      const int k = i - 512; int t;
      if (k < 8) t = 250 + k; else if (k < 16) t = 8184 + (k - 8); else if (k < 20) t = k - 16; else t = r & 8191;
      check_select(p, (r >> 13) & 3, t, lds);
    } else if (i < 704) {
      const int k = i - 640; const int m = (k < 4) ? k : (k < 8 ? kM - 1 - (k - 4) : (int)(r & (kM - 1)));
      check_inproj(p, m, lds);
    } else check_misc(p, i - 704);
  }
}
#endif

#define XB_TMO      128
#define XB_XCNT(j)  (256  + 64 * (j))
#define XB_XSUB(j)  (1280 + 64 * (j))
#define XB_XGEN(j)  (2304 + 64 * (j))
#define XB_TOP      3328
#define XB_TOPGEN   3392
#define XCD_BAR_WORDS 3456
#define XB_SPIN_CAP (1u << 22)
#define LAS __attribute__((address_space(3)))
DI unsigned xb_ld(unsigned* p) { return __hip_atomic_load(p, __ATOMIC_RELAXED, __HIP_MEMORY_SCOPE_AGENT); }
DI unsigned xb_add(unsigned* p, unsigned v) { return __hip_atomic_fetch_add(p, v, __ATOMIC_RELAXED, __HIP_MEMORY_SCOPE_AGENT); }
DI unsigned xb_xcc_id() { return (unsigned)__builtin_amdgcn_s_getreg((3 << 11) | 20) & 0xFu; }
#define XB_SPIN(cond, bar) do { unsigned _sp = 0; while (cond) { __builtin_amdgcn_s_sleep(1); \
    if ((++_sp & 255u) == 0u) { if (xb_ld(&(bar)[XB_TMO])) break; if (_sp > XB_SPIN_CAP) { atomicAdd(&(bar)[XB_TMO], 1u); break; } } } } while (0)
struct XcdBarrier { unsigned* bar; unsigned x; volatile LAS unsigned* st; };
DI XcdBarrier xcd_barrier_post(unsigned* bar, volatile LAS unsigned* st) {
  XcdBarrier b; b.bar = bar; b.x = xb_xcc_id(); b.st = st;
  if (threadIdx.x == 0) (void)xb_add(&bar[XB_XCNT(b.x)], 1u);
  return b;
}
DI void xcd_barrier_complete(unsigned* bar, unsigned x, unsigned& nloc, unsigned& nx) {
  const unsigned G = gridDim.x * gridDim.y * gridDim.z;
  unsigned sum, cnt, mine, sp = 0u;
  for (;;) {
    sum = 0u; cnt = 0u; mine = 0u;
#pragma unroll
    for (unsigned j = 0; j < 16; ++j) { const unsigned c = xb_ld(&bar[XB_XCNT(j)]); sum += c; cnt += (c > 0u) ? 1u : 0u; mine = (j == x) ? c : mine; }
    if (sum == G) break;
    __builtin_amdgcn_s_sleep(1);
    if ((++sp & 255u) == 0u) { if (xb_ld(&bar[XB_TMO])) break; if (sp > XB_SPIN_CAP) { atomicAdd(&bar[XB_TMO], 1u); break; } }
  }
  nloc = mine > 0u ? mine : 1u; nx = cnt > 0u ? cnt : 1u;
}
DI void xcd_barrier(const XcdBarrier& b) {
  asm volatile("s_waitcnt vmcnt(0)" ::: "memory");
  __syncthreads();
  if (threadIdx.x == 0) {
    unsigned* bar = b.bar;
    __builtin_amdgcn_s_waitcnt(0);
    unsigned nloc = b.st[0], nx = b.st[1];
    if (nloc == 0u) { xcd_barrier_complete(bar, b.x, nloc, nx); b.st[0] = nloc; b.st[1] = nx; }
    const unsigned old = xb_add(&bar[XB_XSUB(b.x)], 1u);
    const unsigned gen = old / nloc;
    if (old + 1u == (gen + 1u) * nloc) {
      __builtin_amdgcn_fence(__ATOMIC_RELEASE, "agent");
      asm volatile("s_waitcnt vmcnt(0)" ::: "memory");
      const unsigned og = xb_add(&bar[XB_TOP], 1u);
      const unsigned tg = og / nx;
      if (og + 1u == (tg + 1u) * nx) xb_add(&bar[XB_TOPGEN], 1u);
      else XB_SPIN(xb_ld(&bar[XB_TOPGEN]) == tg, bar);
      __builtin_amdgcn_fence(__ATOMIC_ACQUIRE, "agent");
      xb_add(&bar[XB_XGEN(b.x)], 1u);
      asm volatile("s_waitcnt vmcnt(0)" ::: "memory");
    } else {
      XB_SPIN(xb_ld(&bar[XB_XGEN(b.x)]) == gen, bar);
      __builtin_amdgcn_fence(__ATOMIC_ACQUIRE, "agent");
      asm volatile("s_waitcnt vmcnt(0)" ::: "memory");
    }
  }
  __syncthreads();
}
DI int next_item(unsigned* cnt, int* slot) {
  __syncthreads();
  if (threadIdx.x == 0) *slot = (int)atomicAdd(cnt, 1u);
  __syncthreads();
  return __builtin_amdgcn_readfirstlane(*slot);
}

__global__ void __launch_bounds__(256, 2) mega(Params p_in) {
  extern __shared__ __attribute__((aligned(16))) char lds[];
  int* slot = (int*)(lds + 65536 + 10240);
  volatile LAS unsigned* xst = (volatile LAS unsigned*)(LAS char*)(lds + 65536 + 10240 + 16);
  XcdBarrier xbar;
  const unsigned xcc = xb_xcc_id() & 7u;
  if (p_in.coop) {
    if (threadIdx.x == 0) { xst[0] = 0u; xst[1] = 0u; xst[2] = 0u; xst[3] = 0u; }
    __syncthreads();
    xbar = xcd_barrier_post((unsigned*)(p_in.ws + OFF_BAR), xst);
  }
  char* ws; unsigned* cnt;
  const Params& p = p_in;
  for (int ph = p_in.phase_begin; ph < p_in.phase_end; ++ph) {
    { size_t z = 0; asm volatile("" : "+s"(z)); ws = p_in.ws + z; }
    cnt = (unsigned*)(ws + OFF_CNT);
    for (int rep = 0; rep < 2; ++rep) {
    if (rep == 1) { if (ph == 0 || !((REPEAT_MASK >> ((ph - 1) & 7)) & 1)) break; if (p_in.coop) xcd_barrier(xbar); cnt += 1024; }
    if (ph == 0) {
      if (HAS(8)) init_phase(p, lds);
    } else {
      const int l = (ph - 1) >> 3, s = (ph - 1) & 7;
      if (HAS(0) && s == 0) {
        gemm_phase<EPI_INPROJ>(p, (const u16*)(ws + OFF_WIN) + (size_t)l * kNPAD * kD, (const u16*)(ws + OFF_XB), kNPAD, kD, l, lds, cnt + 256 + ph * 8, slot, xcc);
      } else if (HAS(1) && s == 1) {
        unsigned* c = cnt + l;
        constexpr int nitems = 16 + 128 + kM / 4;
        for (int i = next_item(c, slot); i < nitems; i = next_item(c, slot)) {
          if (i < 16) cumsum_item(p, i, lds);
          else if (i < 144) kmean_item(p, i - 16);
          else { const int k = i - 144; select_item(p, k & 3, 4 * (2047 - (k >> 2)), lds); }
        }
      } else if (HAS(2) && s == 2) {
        for (int pass = 0; pass < 2; ++pass) {
#pragma unroll 1
          for (int mode = 0; mode < 4; ++mode) {
            XQ q; q.c = cnt + 600 + (l * 4 + mode) * 8; q.step = pass; q.xcc = xcc;
            const int max_step = pass ? 8 : 1;
            for (int v = xq_pull(q, 128, slot, max_step); v >= 0; v = xq_pull(q, 128, slot, max_step)) {
              const int xq = v >> 7, tk = v & 127; const int bh = 2 * xq + (tk & 1), j = tk >> 1;
              if (mode == 0) attn_item<M_FOX>(p, bh >> 2, bh & 3, 63 - j, lds);
              else if (mode == 1) attn_item<M_DSA>(p, bh >> 2, bh & 3, 63 - j, lds);
              else if (mode == 2) attn_item<M_MOBA>(p, bh >> 2, bh & 3, 63 - j, lds);
              else attn_item<M_DIL>(p, bh >> 2, bh & 3, j, lds);
            }
          }
        }
      } else if (HAS(3) && s == 3) {
        gemm_phase<EPI_RESID>(p, (const u16*)(ws + OFF_WO) + (size_t)l * kD * kD, (const u16*)(ws + OFF_O), kD, kD, l, lds, cnt + 256 + ph * 8, slot, xcc);
      } else if (HAS(4) && s == 4) {
        ln_phase(p, p.ln1_g + l * kD, p.ln1_b + l * kD, false);
      } else if (HAS(5) && s == 5) {
        gemm_phase<EPI_RELU2>(p, (const u16*)(ws + OFF_WUP) + (size_t)l * kDFF * kD, (const u16*)(ws + OFF_XB), kDFF, kD, l, lds, cnt + 256 + ph * 8, slot, xcc);
      } else if (HAS(6) && s == 6) {
        gemm_phase<EPI_RESID>(p, (const u16*)(ws + OFF_WDN) + (size_t)l * kD * kDFF, (const u16*)(ws + OFF_QKV), kD, kDFF, l, lds, cnt + 256 + ph * 8, slot, xcc);
      } else if (HAS(7)) {
        ln_phase(p, p.ln2_g + l * kD, p.ln2_b + l * kD, l == kDepth - 1);
      }
    }
    }
    if (p_in.coop && ph + 1 < p_in.phase_end) { if (p_in.pad == 0x5eed) cg::this_grid().sync(); else xcd_barrier(xbar); }
  }
}

#if SELFCHECK
__global__ void __launch_bounds__(256) selfcheck_kernel(Params p) {
  extern __shared__ __attribute__((aligned(16))) char lds[];
  selfcheck_phase(p, lds);
}
__global__ void poison_kernel(Params p) {
  if (blockIdx.x == 0 && threadIdx.x == 0) {
    const unsigned f = ((volatile unsigned*)(p.ws + OFF_CNT))[200];
    if (f) { const int top = 31 - __clz((int)f); p.out[0] = 1024.0f * (float)(1 << top); p.out[1] = (float)f; }
  }
}
#endif

extern "C" void kernel_launch(void* const* d_in, const int* in_sizes, int n_in, void* d_out, int out_size, void* d_ws, size_t ws_size, hipStream_t stream) {
  (void)in_sizes; (void)n_in; (void)out_size;
  if (ws_size < WS_TOTAL) { fprintf(stderr, "workspace too small: %zu < %zu\n", ws_size, (size_t)WS_TOTAL); return; }
  Params p{};
  p.x = (const float*)d_in[0]; p.w_in = (const float*)d_in[1]; p.b_f = (const float*)d_in[2]; p.w_o = (const float*)d_in[3];
  p.ln1_g = (const float*)d_in[4]; p.ln1_b = (const float*)d_in[5]; p.w_up = (const float*)d_in[6]; p.w_down = (const float*)d_in[7];
  p.ln2_g = (const float*)d_in[8]; p.ln2_b = (const float*)d_in[9];
  p.out = (float*)d_out; p.ws = (char*)d_ws; p.pad = 0;
  static int grid_blocks = 0;
  if (!grid_blocks) {
    hipFuncSetAttribute((const void*)mega, hipFuncAttributeMaxDynamicSharedMemorySize, LDS_BYTES);
    int dev = 0, cus = 0, per_cu = 0;
    hipGetDevice(&dev);
    hipDeviceGetAttribute(&cus, hipDeviceAttributeMultiprocessorCount, dev);
    hipOccupancyMaxActiveBlocksPerMultiprocessor(&per_cu, (const void*)mega, 256, LDS_BYTES);
    if (per_cu > 2) per_cu = 2;
    if (per_cu < 1) per_cu = 1;
    grid_blocks = cus * per_cu;
  }
  (void)hipMemsetAsync((char*)d_ws + OFF_CNT, 0, SZ_CNT + SZ_BAR, stream);
  constexpr int nphases = 1 + 8 * kDepth;
#if SELFCHECK
  {
    hipFuncSetAttribute((const void*)selfcheck_kernel, hipFuncAttributeMaxDynamicSharedMemorySize, LDS_BYTES);
    Params pa = p; pa.phase_begin = 0; pa.phase_end = 4; pa.coop = 1;
    void* a1[] = {&pa};
    hipLaunchCooperativeKernel((const void*)mega, dim3(grid_blocks), dim3(256), a1, LDS_BYTES, stream);
    hipLaunchKernelGGL(selfcheck_kernel, dim3(grid_blocks), dim3(256), LDS_BYTES, stream, p);
    hipMemsetAsync((char*)d_ws + OFF_BAR, 0, SZ_BAR, stream);
    Params pb = p; pb.phase_begin = 4; pb.phase_end = nphases; pb.coop = 1;
    void* a2[] = {&pb};
    hipLaunchCooperativeKernel((const void*)mega, dim3(grid_blocks), dim3(256), a2, LDS_BYTES, stream);
    hipLaunchKernelGGL(poison_kernel, dim3(1), dim3(64), 0, stream, p);
  }
#elif ONE_LAUNCH
  p.phase_begin = 0; p.phase_end = nphases; p.coop = 1;
  void* args[] = {&p};
  hipError_t e = hipLaunchCooperativeKernel((const void*)mega, dim3(grid_blocks), dim3(256), args, LDS_BYTES, stream);
  if (e != hipSuccess) fprintf(stderr, "cooperative launch failed: %s (grid %d)\n", hipGetErrorString(e), grid_blocks);
#else
  for (int ph = 0; ph < nphases; ++ph) {
    p.phase_begin = ph; p.phase_end = ph + 1; p.coop = 0;
    hipLaunchKernelGGL(mega, dim3(grid_blocks), dim3(256), LDS_BYTES, stream, p);
  }
#endif
}
```

```cpp
#include <hip/hip_runtime.h>
#include <hip/hip_cooperative_groups.h>
#include <cstdio>
#include <cstdint>
namespace cg = cooperative_groups;

#ifndef ONE_LAUNCH
#define ONE_LAUNCH 1
#endif

#ifndef SELFCHECK
#define SELFCHECK 0
#endif
#ifndef REPEAT_MASK
#define REPEAT_MASK 0
#endif
#ifndef PHASE_MASK
#define PHASE_MASK 0x1ff
#endif
#define HAS(s_) ((PHASE_MASK >> (s_)) & 1)
#define DI __device__ __forceinline__
typedef unsigned short u16;
typedef unsigned long long u64;
typedef __attribute__((ext_vector_type(8))) short bf16x8;
typedef __attribute__((ext_vector_type(4))) short s16x4;
typedef __attribute__((ext_vector_type(16))) float f32x16;
typedef __attribute__((ext_vector_type(4))) float f32x4;
typedef __attribute__((ext_vector_type(2))) float f32x2;
typedef __attribute__((ext_vector_type(2))) __bf16 bf16x2_t;
typedef __attribute__((address_space(3))) const char* lds_cptr;
typedef short v4i16_t __attribute__((ext_vector_type(4)));
typedef __attribute__((ext_vector_type(4))) unsigned u32x4;

#define MFMA32(a, b, c) __builtin_amdgcn_mfma_f32_32x32x16_bf16((a), (b), (c), 0, 0, 0)
#define MFMA16(a, b, c) __builtin_amdgcn_mfma_f32_16x16x32_bf16((a), (b), (c), 0, 0, 0)

constexpr int kB = 4, kT = 8192, kD = 1024, kM = kB * kT, kDepth = 4;
constexpr int kNQKV = 3072, kNPAD = 3456, kDFF = 4096, kDIN = 3372;
constexpr float kAlpha = 1.6817928305074290f;
constexpr float kLog2e = 1.4426950408889634f;
constexpr float kQScale = 0.125f * 1.4426950408889634f;
constexpr float kLnEps = 1e-5f;

constexpr size_t SZ_WIN = (size_t)kDepth * kNPAD * kD * 2;
constexpr size_t SZ_WO = (size_t)kDepth * kD * kD * 2;
constexpr size_t SZ_WUP = (size_t)kDepth * kDFF * kD * 2;
constexpr size_t SZ_WDN = SZ_WUP;
constexpr size_t SZ_XB = (size_t)kM * kD * 2;
constexpr size_t SZ_QKV = (size_t)kM * kNQKV * 2;
constexpr size_t SZ_O = (size_t)kM * kD * 2;
constexpr size_t SZ_MASK = (size_t)kM * 128 * 8;
constexpr size_t SZ_IDXQ = (size_t)kM * 256 * 2;
constexpr size_t SZ_IDXK = (size_t)kM * 32 * 2;
constexpr size_t SZ_WI = (size_t)kM * 8 * 4;
constexpr size_t SZ_LOGF = (size_t)kM * 4 * 4;
constexpr size_t SZ_CB = SZ_LOGF;
constexpr size_t SZ_KMEAN = (size_t)kB * 32 * 4 * 64 * 2;
constexpr size_t SZ_R32 = (size_t)kT * 32 * 2 * 4;
constexpr size_t SZ_R16 = (size_t)kT * 16 * 2 * 4;
constexpr size_t SZ_CNT = 8192;
constexpr size_t OFF_WIN = 0;
constexpr size_t OFF_WO = OFF_WIN + SZ_WIN;
constexpr size_t OFF_WUP = OFF_WO + SZ_WO;
constexpr size_t OFF_WDN = OFF_WUP + SZ_WUP;
constexpr size_t OFF_XB = OFF_WDN + SZ_WDN;
constexpr size_t OFF_QKV = OFF_XB + SZ_XB;
constexpr size_t OFF_O = OFF_QKV + SZ_QKV;
constexpr size_t OFF_MASK = OFF_O + SZ_O;
constexpr size_t OFF_IDXQ = OFF_MASK + SZ_MASK;
constexpr size_t OFF_IDXK = OFF_IDXQ + SZ_IDXQ;
constexpr size_t OFF_WI = OFF_IDXK + SZ_IDXK;
constexpr size_t OFF_LOGF = OFF_WI + SZ_WI;
constexpr size_t OFF_CB = OFF_LOGF + SZ_LOGF;
constexpr size_t OFF_KMEAN = OFF_CB + SZ_CB;
constexpr size_t OFF_R32 = OFF_KMEAN + SZ_KMEAN;
constexpr size_t OFF_R16 = OFF_R32 + SZ_R32;
constexpr size_t OFF_CNT = OFF_R16 + SZ_R16;
constexpr size_t OFF_BAR = OFF_CNT + SZ_CNT;
constexpr size_t SZ_BAR = 16384;
constexpr size_t OFF_KMAX = OFF_BAR + SZ_BAR;
constexpr size_t WS_TOTAL = OFF_KMAX + 256;

constexpr int LDS_BYTES = 65536 + 4096 + 2048 + 4096 + 64;

struct Params {
  const float* x; const float* w_in; const float* b_f; const float* w_o; const float* ln1_g; const float* ln1_b;
  const float* w_up; const float* w_down; const float* ln2_g; const float* ln2_b;
  float* out; char* ws;
  int phase_begin, phase_end, coop, pad;
};

DI unsigned pack2(float a, float b) { f32x2 v = {a, b}; bf16x2_t r = __builtin_convertvector(v, bf16x2_t); return __builtin_bit_cast(unsigned, r); }
DI u16 f2bf(float a) { return (u16)(pack2(a, 0.f) & 0xffffu); }
DI int crow(int r, int hi) { return (r & 3) + 8 * (r >> 2) + 4 * hi; }
DI s16x4 vtr(lds_cptr p) { return __builtin_bit_cast(s16x4, __builtin_amdgcn_ds_read_tr16_b64_v4i16((__attribute__((address_space(3))) v4i16_t*)p)); }
DI float ex2(float x) { return __builtin_amdgcn_exp2f(x); }
DI unsigned okey(float f) { unsigned u = __float_as_uint(f); return (u & 0x80000000u) ? ~u : (u | 0x80000000u); }

DI int tidx() { int t = threadIdx.x; asm volatile("" : "+v"(t)); return t; }
DI char* wsp(const Params& p) { size_t z = 0; asm volatile("" : "+s"(z)); return p.ws + z; }
DI float* outp(const Params& p) { size_t z = 0; asm volatile("" : "+s"(z)); return p.out + z; }

DI int refcol(int n) {
  if (n < 768) return n;
  if (n < 1536) return n + 4;
  if (n < 2304) return 1836 + (n - 1536);
  if (n < 3072) return 2604 + (n - 2304);
  if (n < 3328) return 1540 + (n - 3072);
  if (n < 3360) return 1796 + (n - 3328);
  if (n < 3368) return 1828 + (n - 3360);
  if (n < 3372) return 768 + (n - 3368);
  return -1;
}

DI void convert_tile(const float* __restrict__ src, int Nsrc, u16* __restrict__ dst, int K, int n0, int k0, bool remap, float* lds) {
  const int tid = tidx();
#pragma unroll 4
  for (int e = 0; e < 16; ++e) {
    const int idx = tid + 256 * e; const int k = idx >> 6, n = idx & 63;
    const int c = remap ? refcol(n0 + n) : (n0 + n);
    const float v = (c >= 0) ? src[(size_t)(k0 + k) * Nsrc + c] : 0.f;
    lds[k * 65 + n] = v;
  }
  __syncthreads();
#pragma unroll
  for (int e = 0; e < 2; ++e) {
    const int idx = tid + 256 * e; const int n = idx >> 3, ch = idx & 7;
    uint4 o;
    o.x = pack2(lds[(ch * 8 + 0) * 65 + n], lds[(ch * 8 + 1) * 65 + n]);
    o.y = pack2(lds[(ch * 8 + 2) * 65 + n], lds[(ch * 8 + 3) * 65 + n]);
    o.z = pack2(lds[(ch * 8 + 4) * 65 + n], lds[(ch * 8 + 5) * 65 + n]);
    o.w = pack2(lds[(ch * 8 + 6) * 65 + n], lds[(ch * 8 + 7) * 65 + n]);
    *(uint4*)(dst + (size_t)(n0 + n) * K + k0 + ch * 8) = o;
  }
  __syncthreads();
}

DI void init_phase(const Params& p, char* lds) {
  char* ws = wsp(p);
  constexpr int per_layer = 864 + 256 + 1024 + 1024;
  for (int idx = blockIdx.x; idx < per_layer * kDepth; idx += gridDim.x) {
    const int l = idx / per_layer; int r = idx % per_layer;
    if (r < 864) {
      convert_tile(p.w_in + (size_t)l * kD * kDIN, kDIN, (u16*)(ws + OFF_WIN) + (size_t)l * kNPAD * kD, kD, (r / 16) * 64, (r % 16) * 64, true, (float*)lds);
    } else if (r < 1120) {
      r -= 864;
      convert_tile(p.w_o + (size_t)l * kD * kD, kD, (u16*)(ws + OFF_WO) + (size_t)l * kD * kD, kD, (r / 16) * 64, (r % 16) * 64, false, (float*)lds);
    } else if (r < 2144) {
      r -= 1120;
      convert_tile(p.w_up + (size_t)l * kD * kDFF, kDFF, (u16*)(ws + OFF_WUP) + (size_t)l * kDFF * kD, kD, (r / 16) * 64, (r % 16) * 64, false, (float*)lds);
    } else {
      r -= 2144;
      convert_tile(p.w_down + (size_t)l * kDFF * kD, kD, (u16*)(ws + OFF_WDN) + (size_t)l * kD * kDFF, kDFF, (r / 64) * 64, (r % 64) * 64, false, (float*)lds);
    }
  }
  {
    const float4* src = (const float4*)p.x; uint2* xb = (uint2*)(ws + OFF_XB);
    const size_t n4 = (size_t)kM * kD / 4;
    for (size_t i = (size_t)blockIdx.x * 256 + tidx(); i < n4; i += (size_t)gridDim.x * 256) {
      const float4 v = src[i]; uint2 o; o.x = pack2(v.x, v.y); o.y = pack2(v.z, v.w); xb[i] = o;
    }
  }
  {
    float2* r32 = (float2*)(ws + OFF_R32); float2* r16 = (float2*)(ws + OFF_R16);
    for (int i = blockIdx.x * 256 + tidx(); i < kT * 48; i += gridDim.x * 256) {
      if (i < kT * 32) {
        const int t = i >> 5, f = i & 31; const float inv = powf(10000.0f, -(float)f / 32.0f); const float ang = (float)t * inv;
        double s, c; sincos((double)ang, &s, &c); r32[i] = make_float2((float)c, (float)s);
      } else {
        const int k = i - kT * 32; const int t = k >> 4, f = k & 15; const float inv = powf(10000.0f, -(float)f / 16.0f); const float ang = (float)t * inv;
        double s, c; sincos((double)ang, &s, &c); r16[k] = make_float2((float)c, (float)s);
      }
    }
  }
}

enum { EPI_INPROJ = 0, EPI_RESID = 1, EPI_RELU2 = 2 };

DI float logsigmoid(float z) { return fminf(z, 0.f) - log1pf(expf(-fabsf(z))); }

template <int EPI>
DI void gemm_tile(const Params& p, const u16* __restrict__ Wt, const u16* __restrict__ X, const int K, const int m0, const int n0, const int layer, char* lds) {
  const int tid = tidx(), lane = tid & 63, wid = __builtin_amdgcn_readfirstlane(tid >> 6), r32 = lane & 31, hi = lane >> 5;
  const int wm = wid & 1, wn = wid >> 1;
  f32x16 acc[2][4];
#pragma unroll
  for (int i = 0; i < 2; ++i)
#pragma unroll
    for (int j = 0; j < 4; ++j)
#pragma unroll
      for (int r = 0; r < 16; ++r) acc[i][j][r] = 0.f;
  char* Ws = lds; char* Xs = lds + 18432;
  const int srow = tid >> 3, sch = tid & 7;
  const u16* wsrc = Wt + (size_t)(n0 + srow) * K + sch * 8;
  const u16* xsrc = X + (size_t)(m0 + srow) * K + sch * 8;
  u32x4 w0, w1, w2, w3, x0, x1, x2, x3, x4, x5, x6, x7;
#define GLD(e, koff) *(const u32x4*)(wsrc + (size_t)(32 * (e)) * K + (koff))
#define GLDX(e, koff) *(const u32x4*)(xsrc + (size_t)(32 * (e)) * K + (koff))
  w0 = GLD(0, 0); w1 = GLD(1, 0); w2 = GLD(2, 0); w3 = GLD(3, 0);
  x0 = GLDX(0, 0); x1 = GLDX(1, 0); x2 = GLDX(2, 0); x3 = GLDX(3, 0); x4 = GLDX(4, 0); x5 = GLDX(5, 0); x6 = GLDX(6, 0); x7 = GLDX(7, 0);
  const int nk = K >> 6;
  for (int kt = 0; kt < nk; ++kt) {
    __syncthreads();
    *(u32x4*)(Ws + (srow + 0) * 144 + sch * 16) = w0; *(u32x4*)(Ws + (srow + 32) * 144 + sch * 16) = w1;
    *(u32x4*)(Ws + (srow + 64) * 144 + sch * 16) = w2; *(u32x4*)(Ws + (srow + 96) * 144 + sch * 16) = w3;
    *(u32x4*)(Xs + (srow + 0) * 144 + sch * 16) = x0; *(u32x4*)(Xs + (srow + 32) * 144 + sch * 16) = x1;
    *(u32x4*)(Xs + (srow + 64) * 144 + sch * 16) = x2; *(u32x4*)(Xs + (srow + 96) * 144 + sch * 16) = x3;
    *(u32x4*)(Xs + (srow + 128) * 144 + sch * 16) = x4; *(u32x4*)(Xs + (srow + 160) * 144 + sch * 16) = x5;
    *(u32x4*)(Xs + (srow + 192) * 144 + sch * 16) = x6; *(u32x4*)(Xs + (srow + 224) * 144 + sch * 16) = x7;
    __syncthreads();
    if (kt + 1 < nk) {
      const int ko = (kt + 1) * 64;
      w0 = GLD(0, ko); w1 = GLD(1, ko); w2 = GLD(2, ko); w3 = GLD(3, ko);
      x0 = GLDX(0, ko); x1 = GLDX(1, ko); x2 = GLDX(2, ko); x3 = GLDX(3, ko); x4 = GLDX(4, ko); x5 = GLDX(5, ko); x6 = GLDX(6, ko); x7 = GLDX(7, ko);
    }
    __builtin_amdgcn_sched_barrier(0);
#pragma unroll
    for (int kk = 0; kk < 4; ++kk) {
      bf16x8 wf[2], xf[4];
#pragma unroll
      for (int i = 0; i < 2; ++i) wf[i] = *(const bf16x8*)(Ws + (wn * 64 + i * 32 + r32) * 144 + kk * 32 + hi * 16);
#pragma unroll
      for (int j = 0; j < 4; ++j) xf[j] = *(const bf16x8*)(Xs + (wm * 128 + j * 32 + r32) * 144 + kk * 32 + hi * 16);
#pragma unroll
      for (int i = 0; i < 2; ++i)
#pragma unroll
        for (int j = 0; j < 4; ++j) acc[i][j] = MFMA32(wf[i], xf[j], acc[i][j]);
    }
  }
  const int nb = n0 + wn * 64, mb = m0 + wm * 128;
  char* ws = wsp(p);
  __syncthreads();
  char* stg = lds + wid * 9216;
  if (EPI == EPI_RESID) {
    float* out = outp(p);
    const bool first_res = (layer == 0 && K == kD);
    const u16* xbres = (const u16*)(ws + OFF_XB);
#pragma unroll
    for (int j = 0; j < 4; ++j) {
#pragma unroll
      for (int i = 0; i < 2; ++i)
#pragma unroll
        for (int g = 0; g < 4; ++g) {
          f32x4 v = {acc[i][j][4 * g + 0], acc[i][j][4 * g + 1], acc[i][j][4 * g + 2], acc[i][j][4 * g + 3]};
          *(f32x4*)(stg + r32 * 272 + (i * 32 + 8 * g + 4 * hi) * 4) = v;
        }
      __builtin_amdgcn_fence(__ATOMIC_RELEASE, "wavefront");
#pragma unroll
      for (int it = 0; it < 8; ++it) {
        const int row = it * 4 + (lane >> 4), ch = lane & 15;
        const f32x4 a = *(const f32x4*)(stg + row * 272 + ch * 16);
        const size_t eo = (size_t)(mb + j * 32 + row) * kD + nb + ch * 4;
        f32x4 v;
        if (first_res) v = *(const f32x4*)(p.x + eo);
        else { const uint2 xv = *(const uint2*)(xbres + eo); v = (f32x4){__uint_as_float(xv.x << 16), __uint_as_float(xv.x & 0xffff0000u), __uint_as_float(xv.y << 16), __uint_as_float(xv.y & 0xffff0000u)}; }
        v = v * kAlpha + a;
        *(f32x4*)(out + eo) = v;
      }
      __builtin_amdgcn_fence(__ATOMIC_RELEASE, "wavefront");
    }
  } else if (EPI == EPI_RELU2) {
    u16* H = (u16*)(ws + OFF_QKV);
#pragma unroll
    for (int jp = 0; jp < 2; ++jp) {
#pragma unroll
      for (int jj = 0; jj < 2; ++jj)
#pragma unroll
        for (int i = 0; i < 2; ++i)
#pragma unroll
          for (int g = 0; g < 4; ++g) {
            const int j = jp * 2 + jj;
            float a0 = fmaxf(acc[i][j][4 * g + 0], 0.f), a1 = fmaxf(acc[i][j][4 * g + 1], 0.f), a2 = fmaxf(acc[i][j][4 * g + 2], 0.f), a3 = fmaxf(acc[i][j][4 * g + 3], 0.f);
            uint2 o; o.x = pack2(a0 * a0, a1 * a1); o.y = pack2(a2 * a2, a3 * a3);
            *(uint2*)(stg + (jj * 32 + r32) * 144 + (i * 32 + 8 * g + 4 * hi) * 2) = o;
          }
      __builtin_amdgcn_fence(__ATOMIC_RELEASE, "wavefront");
#pragma unroll
      for (int it = 0; it < 8; ++it) {
        const int row = it * 8 + (lane >> 3), ch = lane & 7;
        const u32x4 v = *(const u32x4*)(stg + row * 144 + ch * 16);
        *(u32x4*)(H + (size_t)(mb + jp * 64 + row) * kDFF + nb + ch * 8) = v;
      }
      __builtin_amdgcn_fence(__ATOMIC_RELEASE, "wavefront");
    }
  } else {
    u16* QKV = (u16*)(ws + OFF_QKV); u16* IDXQ = (u16*)(ws + OFF_IDXQ); u16* IDXK = (u16*)(ws + OFF_IDXK);
    float* WI = (float*)(ws + OFF_WI); float* LOGF = (float*)(ws + OFF_LOGF);
    const float* rope32 = (const float*)(ws + OFF_R32); const float* rope16 = (const float*)(ws + OFF_R16);
    if (nb < kNQKV) {
      const int seg = nb >> 8; const int typ = seg % 3; const bool dorope = (seg >= 3) && (typ != 2);
      const float sc = (typ == 0) ? kQScale : 1.f;
#pragma unroll
      for (int jp = 0; jp < 2; ++jp) {
#pragma unroll
        for (int jj = 0; jj < 2; ++jj) {
          const int j = jp * 2 + jj;
          const int m = mb + j * 32 + r32; const int t = m & (kT - 1);
#pragma unroll
          for (int g = 0; g < 4; ++g) {
            float a0[4], a1[4];
#pragma unroll
            for (int e = 0; e < 4; ++e) { a0[e] = acc[0][j][4 * g + e]; a1[e] = acc[1][j][4 * g + e]; }
            if (dorope) {
              const float4* rp = (const float4*)(rope32 + ((size_t)t * 32 + 8 * g + 4 * hi) * 2);
              const float4 c01 = rp[0], c23 = rp[1];
              const float cs[4] = {c01.x, c01.z, c23.x, c23.z}; const float sn[4] = {c01.y, c01.w, c23.y, c23.w};
#pragma unroll
              for (int e = 0; e < 4; ++e) { const float x1 = a0[e], x2 = a1[e]; a0[e] = x1 * cs[e] - x2 * sn[e]; a1[e] = x2 * cs[e] + x1 * sn[e]; }
            }
            uint2 o0, o1;
            o0.x = pack2(a0[0] * sc, a0[1] * sc); o0.y = pack2(a0[2] * sc, a0[3] * sc);
            o1.x = pack2(a1[0] * sc, a1[1] * sc); o1.y = pack2(a1[2] * sc, a1[3] * sc);
            char* d = stg + (jj * 32 + r32) * 144 + (8 * g + 4 * hi) * 2;
            *(uint2*)d = o0; *(uint2*)(d + 64) = o1;
          }
        }
        __builtin_amdgcn_fence(__ATOMIC_RELEASE, "wavefront");
#pragma unroll
        for (int it = 0; it < 8; ++it) {
          const int row = it * 8 + (lane >> 3), ch = lane & 7;
          const u32x4 v = *(const u32x4*)(stg + row * 144 + ch * 16);
          *(u32x4*)(QKV + (size_t)(mb + jp * 64 + row) * kNQKV + nb + ch * 8) = v;
        }
        __builtin_amdgcn_fence(__ATOMIC_RELEASE, "wavefront");
      }
    } else if (nb <= 3328) {
#pragma unroll
      for (int j = 0; j < 4; ++j) {
        const int m = mb + j * 32 + r32; const int t = m & (kT - 1);
#pragma unroll
        for (int i = 0; i < 2; ++i) {
          if (nb == 3328 && i == 1) {
            float4 w; w.x = acc[1][j][0]; w.y = acc[1][j][1]; w.z = acc[1][j][2]; w.w = acc[1][j][3];
            *(float4*)(WI + (size_t)m * 8 + 4 * hi) = w;
            if (hi == 0) {
              const float* bf = p.b_f + layer * 4;
              float4 f;
              f.x = logsigmoid(acc[1][j][4] + bf[0]); f.y = logsigmoid(acc[1][j][5] + bf[1]);
              f.z = logsigmoid(acc[1][j][6] + bf[2]); f.w = logsigmoid(acc[1][j][7] + bf[3]);
              *(float4*)(LOGF + (size_t)m * 4) = f;
            }
          } else {
#pragma unroll
            for (int gg = 0; gg < 2; ++gg) {
              const float4* rp = (const float4*)(rope16 + ((size_t)t * 16 + 8 * gg + 4 * hi) * 2);
              const float4 c01 = rp[0], c23 = rp[1];
              const float cs[4] = {c01.x, c01.z, c23.x, c23.z}; const float sn[4] = {c01.y, c01.w, c23.y, c23.w};
              float o1[4], o2[4];
#pragma unroll
              for (int e = 0; e < 4; ++e) { const float x1 = acc[i][j][4 * gg + e], x2 = acc[i][j][4 * gg + 8 + e]; o1[e] = x1 * cs[e] - x2 * sn[e]; o2[e] = x2 * cs[e] + x1 * sn[e]; }
              uint2 p1, p2; p1.x = pack2(o1[0], o1[1]); p1.y = pack2(o1[2], o1[3]); p2.x = pack2(o2[0], o2[1]); p2.y = pack2(o2[2], o2[3]);
              u16* dst = (nb == 3328) ? (IDXK + (size_t)m * 32 + 8 * gg + 4 * hi) : (IDXQ + (size_t)m * 256 + (nb - kNQKV) + i * 32 + 8 * gg + 4 * hi);
              *(uint2*)dst = p1; *(uint2*)(dst + 16) = p2;
            }
          }
        }
      }
    }
  }
}
#undef GLD
#undef GLDX
struct XQ { unsigned* c; int step; unsigned xcc; };
DI int xq_pull(XQ& q, const int per_queue, int* slot, const int max_step) {
  for (;;) {
    if (q.step >= max_step) return -1;
    const int xq = (int)((q.xcc + (unsigned)q.step) & 7u);
    __syncthreads();
    if (threadIdx.x == 0) *slot = (int)atomicAdd(q.c + xq, 1u);
    __syncthreads();
    const int t = __builtin_amdgcn_readfirstlane(*slot);
    if (t < per_queue) return xq * per_queue + t;
    ++q.step;
  }
}

template <int EPI>
DI void gemm_phase(const Params& p, const u16* Wt, const u16* X, const int N, const int K, const int layer, char* lds, unsigned* qcnt, int* slot, const unsigned xcc) {
  const int ntn = N >> 7; const int per_queue = 16 * ntn;
  XQ q; q.c = qcnt; q.step = 0; q.xcc = xcc;
  for (int v = xq_pull(q, per_queue, slot, 8); v >= 0; v = xq_pull(q, per_queue, slot, 8)) {
    const int xq = v / per_queue, tk = v % per_queue;
    const int band = xq * 2 + tk / (8 * ntn); const int r = tk % (8 * ntn);
    const int nt = (r >> 6) * 8 + ((r & 63) >> 3), mt = band * 8 + (r & 7);
    gemm_tile<EPI>(p, Wt, X, K, mt * 256, nt * 128, layer, lds);
  }
}

DI float wave_sum(float v) {
#pragma unroll
  for (int off = 32; off > 0; off >>= 1) v += __shfl_xor(v, off);
  return v;
}
DI void ln_phase(const Params& p, const float* __restrict__ g, const float* __restrict__ bta, const bool last) {
  const int lane = tidx() & 63, wid = __builtin_amdgcn_readfirstlane(tidx() >> 6);
  float* x = outp(p); u16* xb = (u16*)(wsp(p) + OFF_XB);
  float4 gg[4], bb[4];
#pragma unroll
  for (int i = 0; i < 4; ++i) { gg[i] = *(const float4*)(g + (lane + 64 * i) * 4); bb[i] = *(const float4*)(bta + (lane + 64 * i) * 4); }
  for (int row = blockIdx.x * 4 + wid; row < kM; row += gridDim.x * 4) {
    float4* xr = (float4*)(x + (size_t)row * kD);
    float4 v[4]; float s = 0.f;
#pragma unroll
    for (int i = 0; i < 4; ++i) { v[i] = xr[lane + 64 * i]; s += v[i].x + v[i].y + v[i].z + v[i].w; }
    const float mean = wave_sum(s) * (1.0f / kD);
    float q = 0.f;
#pragma unroll
    for (int i = 0; i < 4; ++i) { v[i].x -= mean; v[i].y -= mean; v[i].z -= mean; v[i].w -= mean; q += v[i].x * v[i].x + v[i].y * v[i].y + v[i].z * v[i].z + v[i].w * v[i].w; }
    const float rstd = 1.0f / sqrtf(wave_sum(q) * (1.0f / kD) + kLnEps);
#pragma unroll
    for (int i = 0; i < 4; ++i) {
      float4 y;
      y.x = v[i].x * rstd * gg[i].x + bb[i].x; y.y = v[i].y * rstd * gg[i].y + bb[i].y;
      y.z = v[i].z * rstd * gg[i].z + bb[i].z; y.w = v[i].w * rstd * gg[i].w + bb[i].w;
      if (last) xr[lane + 64 * i] = y;
      uint2 o; o.x = pack2(y.x, y.y); o.y = pack2(y.z, y.w);
      if (!last) *(uint2*)(xb + (size_t)row * kD + (lane + 64 * i) * 4) = o;
    }
  }
}

DI void cumsum_item(const Params& p, const int bh, char* lds) {
  const int tid = tidx(); const int b = bh >> 2, h = bh & 3;
  const float* LOGF = (const float*)(wsp(p) + OFF_LOGF); float* CB = (float*)(wsp(p) + OFF_CB);
  float* part = (float*)lds;
  const float* src = LOGF + ((size_t)b * kT + tid * 32) * 4 + h;
  float s = 0.f;
  for (int i = 0; i < 32; ++i) s += src[i * 4];
  part[tid] = s;
  __syncthreads();
  float pre = 0.f;
  for (int i = 0; i < tid; ++i) pre += part[i];
  float run = pre;
  float* dst = CB + (size_t)bh * kT + tid * 32;
  for (int i = 0; i < 32; ++i) { run += src[i * 4]; dst[i] = run * kLog2e; }
  __syncthreads();
  {
    const u16* QKV = (const u16*)(wsp(p) + OFF_QKV);
    float mx = 0.f;
    for (int i = 0; i < 32; ++i) {
      const u16* kp = QKV + ((size_t)b * kT + tid * 32 + i) * kNQKV + 256 + h * 64;
      float ss = 0.f;
#pragma unroll
      for (int c = 0; c < 8; ++c) {
        const u32x4 v = *(const u32x4*)(kp + c * 8);
#pragma unroll
        for (int e = 0; e < 4; ++e) { const float a = __uint_as_float(v[e] << 16), bq = __uint_as_float(v[e] & 0xffff0000u); ss += a * a + bq * bq; }
      }
      mx = fmaxf(mx, ss);
    }
    part[tid] = mx;
    __syncthreads();
    if (tid == 0) { float m = 0.f; for (int i = 0; i < 256; ++i) m = fmaxf(m, part[i]); ((float*)(wsp(p) + OFF_KMAX))[bh] = sqrtf(m) * 1.002f; }
    __syncthreads();
  }
}

DI void kmean_item(const Params& p, const int idx) {
  const int tid = tidx(); const int b = idx >> 5, blk = idx & 31;
  const u16* QKV = (const u16*)(wsp(p) + OFF_QKV); u16* KMEAN = (u16*)(wsp(p) + OFF_KMEAN);
  const u16* src = QKV + ((size_t)b * kT + blk * 256) * kNQKV + 2560 + tid;
  float s = 0.f;
  for (int i = 0; i < 256; ++i) s += __uint_as_float((unsigned)src[(size_t)i * kNQKV] << 16);
  KMEAN[(((size_t)b * 32 + blk) * 4 + (tid >> 6)) * 64 + (tid & 63)] = f2bf(s * (1.0f / 256.0f));
}

#if SELFCHECK
DI void sc_flag2(const Params& p, unsigned idx) { atomicOr((unsigned*)(wsp(p) + OFF_CNT) + 200, 1u << idx); }
#endif
DI void select_item(const Params& p, const int b, const int t0, char* lds) {
  const int tid = tidx(), lane = tid & 63, wid = __builtin_amdgcn_readfirstlane(tid >> 6), r32 = lane & 31, hi = lane >> 5;
  u16* S16 = (u16*)lds; unsigned* hist = (unsigned*)(lds + 65536); u16* tl_idx = (u16*)(lds + 65536 + 4096); float* tl_sc = (float*)(lds + 65536 + 4096 + 2048);
  char* ws = wsp(p);
  const u16* IDXQ = (const u16*)(ws + OFF_IDXQ); const u16* IDXK = (const u16*)(ws + OFF_IDXK); const float* WI = (const float*)(ws + OFF_WI);
  u64* MASK = (u64*)(ws + OFF_MASK);
  const bool all = (t0 + 3 < 256);
  const int npad = (t0 | 127) + 1;
  const size_t rb = (size_t)b * kT;
  if (!all) {
    {
      const int hc = (r32 >> 2) & 1, ii = (r32 & 3) + 4 * (r32 >> 3);
      const int aq = 2 * hc + (ii >> 3), ah = ii & 7;
      const u16* ap = IDXQ + (rb + t0 + aq) * 256 + ah * 32 + hi * 8;
      const bf16x8 af0 = *(const bf16x8*)ap, af1 = *(const bf16x8*)(ap + 16);
      const float* wp = WI + (rb + t0 + 2 * hi) * 8;
      const float4 wa0 = *(const float4*)wp, wa1 = *(const float4*)(wp + 4), wb0 = *(const float4*)(wp + 8), wb1 = *(const float4*)(wp + 12);
      const int nchunks = (t0 + 4 + 31) >> 5;
      const u16* kp = IDXK + (rb + r32) * 32 + hi * 8;
      u16* s_a = S16 + (2 * hi) * 8192 + r32; u16* s_b = s_a + 8192;
      for (int c0 = wid; c0 < nchunks; c0 += 32) {
        bf16x8 k0[8], k1[8];
#pragma unroll
        for (int u = 0; u < 8; ++u) { const int c = min(c0 + 4 * u, nchunks - 1); const u16* q_ = kp + (size_t)c * 32 * 32; k0[u] = *(const bf16x8*)q_; k1[u] = *(const bf16x8*)(q_ + 16); }
        __builtin_amdgcn_sched_barrier(0);
#pragma unroll
        for (int u = 0; u < 8; ++u) {
          const int c = c0 + 4 * u;
          if (c < nchunks) {
            f32x16 acc;
#pragma unroll
            for (int r = 0; r < 16; ++r) acc[r] = 0.f;
            acc = MFMA32(af0, k0[u], acc); acc = MFMA32(af1, k1[u], acc);
            float sa = wa0.x * fmaxf(acc[0], 0.f) + wa0.y * fmaxf(acc[1], 0.f) + wa0.z * fmaxf(acc[2], 0.f) + wa0.w * fmaxf(acc[3], 0.f)
                     + wa1.x * fmaxf(acc[4], 0.f) + wa1.y * fmaxf(acc[5], 0.f) + wa1.z * fmaxf(acc[6], 0.f) + wa1.w * fmaxf(acc[7], 0.f);
            float sb = wb0.x * fmaxf(acc[8], 0.f) + wb0.y * fmaxf(acc[9], 0.f) + wb0.z * fmaxf(acc[10], 0.f) + wb0.w * fmaxf(acc[11], 0.f)
                     + wb1.x * fmaxf(acc[12], 0.f) + wb1.y * fmaxf(acc[13], 0.f) + wb1.z * fmaxf(acc[14], 0.f) + wb1.w * fmaxf(acc[15], 0.f);
            s_a[c * 32] = (u16)(okey(sa + 0.0f) >> 16); s_b[c * 32] = (u16)(okey(sb + 0.0f) >> 16);
          }
        }
      }
    }
    __syncthreads();
  }
  {
    const int q = wid; const int tq = t0 + q; const int nq = tq + 1;
    u16* Sq = S16 + q * 8192; unsigned* hq = hist + q * 256; u16* li = tl_idx + q * 256; float* ls = tl_sc + q * 256; float* qf32 = (float*)hq;
    unsigned thr = 0;
    if (!all) {
      unsigned prefix = 0; int krem = 256; unsigned cnt_eq = 0;
#pragma unroll
      for (int pass = 0; pass < 2; ++pass) {
        { const unsigned z0 = (unsigned)tid >> 30; u32x4 zz = {z0, z0, z0, z0}; *(u32x4*)(hq + lane * 4) = zz; }
        asm volatile("s_waitcnt lgkmcnt(0)" ::: "memory");
        for (int i = lane * 8; i < nq; i += 512) {
          const u32x4 v = *(const u32x4*)(Sq + i);
#pragma unroll
          for (int e = 0; e < 8; ++e) {
            if (i + e < nq) {
              const unsigned key = (e & 1) ? (v[e >> 1] >> 16) : (v[e >> 1] & 0xffffu);
              const bool match = (pass == 0) ? true : ((key >> 8) == prefix);
              if (match) atomicAdd(&hq[(pass == 0) ? (key >> 8) : (key & 255u)], 1u);
            }
          }
        }
        asm volatile("s_waitcnt lgkmcnt(0)" ::: "memory");
        const u32x4 c = *(const u32x4*)(hq + 4 * lane);
        const unsigned s_ = c[0] + c[1] + c[2] + c[3]; unsigned incl = s_;
#pragma unroll
        for (int off = 1; off < 64; off <<= 1) { const unsigned v = __shfl_down(incl, off); if (lane + off < 64) incl += v; }
        const unsigned excl = incl - s_;
        const bool has = (excl < (unsigned)krem) && (incl >= (unsigned)krem);
        unsigned bsel = 0, above = 0, cbin = 0;
        {
          unsigned cum = excl;
          if (cum + c[3] >= (unsigned)krem) { bsel = 4 * lane + 3; above = cum; cbin = c[3]; }
          else { cum += c[3];
            if (cum + c[2] >= (unsigned)krem) { bsel = 4 * lane + 2; above = cum; cbin = c[2]; }
            else { cum += c[2];
              if (cum + c[1] >= (unsigned)krem) { bsel = 4 * lane + 1; above = cum; cbin = c[1]; }
              else { cum += c[1]; bsel = 4 * lane; above = cum; cbin = c[0]; } } }
        }
        const u64 bm = __ballot(has); const int srcl = bm ? (__ffsll((long long)bm) - 1) : 0;
        bsel = __shfl(bsel, srcl); above = __shfl(above, srcl); cbin = __shfl(cbin, srcl);
        prefix = (prefix << 8) | bsel; krem -= (int)above; cnt_eq = cbin;
      }
      thr = prefix;
#if SELFCHECK
      {
        int cg_ = 0, ce_ = 0;
        for (int base = 0; base < nq; base += 64) { const int j = base + lane; const unsigned kk_ = (j < nq) ? (unsigned)Sq[j] : 0u; cg_ += __popcll(__ballot(j < nq && kk_ > thr)); ce_ += __popcll(__ballot(j < nq && kk_ == thr)); }
        if (cg_ != 256 - krem) sc_flag2(p, 19);
        if ((unsigned)ce_ != cnt_eq) sc_flag2(p, 18);
      }
#endif
      if (cnt_eq != (unsigned)krem) {
        int nmem = 0;
        for (int i0 = 0; i0 < nq; i0 += 512) {
          const int i = i0 + lane * 8;
          unsigned mm = 0;
          if (i < nq) {
            const u32x4 v = *(const u32x4*)(Sq + i);
#pragma unroll
            for (int e = 0; e < 8; ++e) {
              const unsigned key = (e & 1) ? (v[e >> 1] >> 16) : (v[e >> 1] & 0xffffu);
              if (i + e < nq && key == thr) mm |= 1u << e;
            }
          }
          u64 anyb = __ballot(mm != 0u);
          while (anyb) {
            const int L = __ffsll((long long)anyb) - 1; anyb &= anyb - 1ull;
            const unsigned m8 = __shfl(mm, L);
#pragma unroll
            for (int e = 0; e < 8; ++e) {
              if ((m8 >> e) & 1u) { if (nmem < 256 && lane == 0) li[nmem] = (u16)(i0 + L * 8 + e); ++nmem; }
            }
          }
        }
        asm volatile("s_waitcnt lgkmcnt(0)" ::: "memory");
        if (nmem <= 256) {
          const float* wr = WI + (rb + tq) * 8;
          for (int m0_ = 0; m0_ < nmem; m0_ += 64) {
            const int m = m0_ + lane;
            if (m < nmem) {
              const int j = li[m];
              const u16* kr = IDXK + (rb + j) * 32;
              float tot = 0.f;
              const u16* qr = IDXQ + (rb + tq) * 256;
#pragma unroll 1
              for (int h = 0; h < 8; ++h) {
                float d_ = 0.f;
#pragma unroll
                for (int c = 0; c < 4; ++c) {
                  const u32x4 qv = *(const u32x4*)(qr + h * 32 + c * 8); const u32x4 kv_ = *(const u32x4*)(kr + c * 8);
#pragma unroll
                  for (int e = 0; e < 4; ++e)
                    d_ += __uint_as_float(qv[e] << 16) * __uint_as_float(kv_[e] << 16) + __uint_as_float(qv[e] & 0xffff0000u) * __uint_as_float(kv_[e] & 0xffff0000u);
                }
                tot += wr[h] * fmaxf(d_, 0.f);
              }
              ls[m] = tot + 0.0f;
            }
          }
          asm volatile("s_waitcnt lgkmcnt(0)" ::: "memory");
          for (int m0_ = 0; m0_ < nmem; m0_ += 64) {
            const int m = m0_ + lane;
            if (m < nmem) {
              const float sm = ls[m]; const int jm = li[m]; int rank = 0;
              for (int o = 0; o < nmem; ++o) { const float so = ls[o]; const int jo = li[o]; rank += (so > sm || (so == sm && jo < jm)) ? 1 : 0; }
              if (rank < krem) Sq[jm] = (u16)0xFFFFu;
            }
          }
        } else {
          int taken = 0;
          for (int base = 0; base < nq; base += 64) {
            const int j = base + lane;
            const bool mem = (j < nq) && ((unsigned)Sq[j < nq ? j : 0] == thr);
            const u64 mb = __ballot(mem);
            if (mem) { const int pos = taken + __popcll(mb & ((1ull << lane) - 1ull)); if (pos < krem) Sq[j] = (u16)0xFFFFu; }
            taken += __popcll(mb);
          }
        }
        asm volatile("s_waitcnt lgkmcnt(0)" ::: "memory");
      } else {
        thr = thr - 1u;
      }
    }
    {
      const int nIt = (npad + 255) >> 8;
      int tot_bits = 0;
      u64* mbase = MASK + ((size_t)(b * 256 + (tq >> 5)) * 128) * 32 + (tq & 31);
      for (int it = 0; it < nIt; ++it) {
        const int kbase = it * 256 + lane * 4;
        unsigned k01 = 0, k23 = 0;
        if (!all) { const uint2 v = *(const uint2*)(Sq + kbase); k01 = v.x; k23 = v.y; }
        const unsigned kv[4] = {k01 & 0xffffu, k01 >> 16, k23 & 0xffffu, k23 >> 16};
        u64 gsel[4];
#pragma unroll
        for (int e = 0; e < 4; ++e) { const bool valid = (kbase + e) <= tq; gsel[e] = __ballot(valid && (all || kv[e] > thr)); }
        u64 wt[4];
#pragma unroll
        for (int tau = 0; tau < 4; ++tau) {
          u64 acc_ = 0;
#pragma unroll
          for (int e = 0; e < 4; ++e) acc_ |= ((gsel[e] >> (16 * tau)) & 0xFFFFull) << (16 * e);
          wt[tau] = acc_;
        }
        const u64 wv = (lane == 0) ? wt[0] : (lane == 1) ? wt[1] : (lane == 2) ? wt[2] : wt[3];
        const int tile = it * 4 + lane;
        if (lane < 4 && tile * 64 < npad) mbase[(size_t)tile * 32] = wv;
#if SELFCHECK
        tot_bits += __popcll(gsel[0]) + __popcll(gsel[1]) + __popcll(gsel[2]) + __popcll(gsel[3]);
#endif
      }
#if SELFCHECK
      if (!all && tot_bits != 256) sc_flag2(p, 16);
      if (!all && tot_bits > 256 + 64) sc_flag2(p, 17);
#endif
    }
  }
  __syncthreads();
}

enum { M_FOX = 0, M_DSA = 1, M_DIL = 2, M_MOBA = 3 };

template <int MODE>
DI void attn_item(const Params& p, const int b, const int h, const int sub, char* lds) {
  const int tid = tidx(), lane = tid & 63, wid = __builtin_amdgcn_readfirstlane(tid >> 6), r32 = lane & 31, hi = lane >> 5;
  char* ws = wsp(p);
  const u16* QKV = (const u16*)(ws + OFF_QKV); u16* O = (u16*)(ws + OFF_O);
  constexpr int grp = MODE;
  const int qcol = grp * 768 + h * 64, kcol = qcol + 256, vcol = qcol + 512;
  const size_t rowbase = (size_t)b * kT;
  int tq, tw_lo, tw_hi, qt = 0, it = 0, res16 = 0;
  if (MODE == M_DIL) { res16 = sub >> 4; it = sub & 15; tq = (it * 32 + r32) * 16 + res16 + 4 * wid; tw_lo = (it * 32) * 16 + res16 + 4 * wid; tw_hi = tw_lo + 31 * 16; }
  else { qt = sub; tq = qt * 128 + wid * 32 + r32; tw_lo = qt * 128 + wid * 32; tw_hi = tw_lo + 31; }
  bf16x8 qf[4];
  {
    const u16* qp = QKV + (rowbase + tq) * kNQKV + qcol + hi * 8;
#pragma unroll
    for (int d0 = 0; d0 < 4; ++d0) qf[d0] = *(const bf16x8*)(qp + d0 * 16);
  }
  const int ntiles = (MODE == M_DIL) ? 26 : (2 * qt + 2);
  unsigned selmask = 0;
  if (MODE == M_MOBA) {
    const int own = qt >> 1;
    const u16* KMEAN = (const u16*)(ws + OFF_KMEAN);
    f32x16 g;
#pragma unroll
    for (int r = 0; r < 16; ++r) g[r] = 0.f;
#pragma unroll
    for (int d0 = 0; d0 < 4; ++d0) {
      const bf16x8 kmf = *(const bf16x8*)(KMEAN + (((size_t)b * 32 + r32) * 4 + h) * 64 + d0 * 16 + hi * 8);
      g = MFMA32(kmf, qf[d0], g);
    }
#pragma unroll
    for (int round = 0; round < 3; ++round) {
      float best = -INFINITY; int bi = 99;
#pragma unroll
      for (int r = 0; r < 16; ++r) {
        const int n = crow(r, hi);
        if (n < own && !((selmask >> n) & 1u) && g[r] > best) { best = g[r]; bi = n; }
      }
      const float ob = __shfl_xor(best, 32); const int obi = __shfl_xor(bi, 32);
      if (ob > best || (ob == best && obi < bi)) { best = ob; bi = obi; }
      if (bi < 32) selmask |= (1u << bi);
    }
    selmask |= (1u << own);
  }
  const u64* mrow = (const u64*)(ws + OFF_MASK) + ((size_t)(b * 256 + (tq >> 5)) * 128) * 32 + (tq & 31);
  const float* cbp = (const float*)(ws + OFF_CB) + (size_t)(b * 4 + h) * kT;

  float m_run = -INFINITY, l_run = 0.f;
  f32x16 o0, o1;
#pragma unroll
  for (int r = 0; r < 16; ++r) { o0[r] = 0.f; o1[r] = 0.f; }
  char* Ks = lds; char* Vs = lds + 9216; float* CBs = (float*)(lds + 18432); float* AL = (float*)(lds + 18688 + wid * 128);
  const int srow = tid >> 3, sch = tid & 7;
  auto tile_desc = [&](const int j, int& lo, int& r) {
    if (MODE == M_DIL) {
      if (j < 12) { r = 16; lo = (it * 32 - 128 + 64 * (j % 3)) * 16 + res16 + 4 * (j / 3); }
      else if (j < 16) { r = 4; lo = (128 * it - 128 + 64 * (j - 12)) * 4 + res16; }
      else { r = 1; lo = 512 * it + res16 - 128 + 64 * (j - 16); }
    } else { r = 1; lo = 64 * j; }
  };
  u32x4 kr0, kr1, vr0, vr1; float cbreg = 0.f;
#define PREFETCH(jj) do { int lo_, r_; tile_desc((jj), lo_, r_); \
    { const int tpos = lo_ + srow * r_; \
      if (MODE != M_DIL || (tpos >= 0 && tpos < kT)) { const u16* base = QKV + (rowbase + tpos) * kNQKV + sch * 8; kr0 = *(const u32x4*)(base + kcol); vr0 = *(const u32x4*)(base + vcol); } \
      else { kr0 = (u32x4){0u, 0u, 0u, 0u}; vr0 = (u32x4){0u, 0u, 0u, 0u}; } } \
    { const int tpos = lo_ + (srow + 32) * r_; \
      if (MODE != M_DIL || (tpos >= 0 && tpos < kT)) { const u16* base = QKV + (rowbase + tpos) * kNQKV + sch * 8; kr1 = *(const u32x4*)(base + kcol); vr1 = *(const u32x4*)(base + vcol); } \
      else { kr1 = (u32x4){0u, 0u, 0u, 0u}; vr1 = (u32x4){0u, 0u, 0u, 0u}; } } \
    if (MODE == M_FOX) { if (tid < 64) cbreg = cbp[lo_ + tid]; } } while (0)
  float ubq = 0.f; bool wdone = false;
  if (MODE == M_FOX) {
    float ss = 0.f;
#pragma unroll
    for (int d0 = 0; d0 < 4; ++d0)
#pragma unroll
      for (int e = 0; e < 8; ++e) { const float a = __uint_as_float((unsigned)(unsigned short)qf[d0][e] << 16); ss += a * a; }
    ss += __shfl_xor(ss, 32);
    ubq = sqrtf(ss) * 1.002f * ((const float*)(ws + OFF_KMAX))[b * 4 + h];
  }
#define TILE_OF(j_) ((MODE == M_FOX) ? (ntiles - 1 - (j_)) : (j_))
  PREFETCH(TILE_OF(0));
  for (int j = 0; j < ntiles; ++j) {
    if (MODE == M_FOX) { if (__syncthreads_and(wdone ? 1 : 0)) break; }
    else __syncthreads();
    *(u32x4*)(Ks + srow * 144 + sch * 16) = kr0; *(u32x4*)(Ks + (srow + 32) * 144 + sch * 16) = kr1;
    *(u32x4*)(Vs + srow * 144 + sch * 16) = vr0; *(u32x4*)(Vs + (srow + 32) * 144 + sch * 16) = vr1;
    if (MODE == M_FOX) { if (tid < 64) CBs[tid] = cbreg; }
    __syncthreads();
    int lo, rs; tile_desc(TILE_OF(j), lo, rs);
    if (j + 1 < ntiles) PREFETCH(TILE_OF(j + 1));
    __builtin_amdgcn_sched_barrier(0);
    bool part;
    if (MODE == M_DIL) part = (lo <= tw_hi) && (lo + 63 * rs >= tw_lo - 128 * rs) && (TILE_OF(j) >= 12 || TILE_OF(j) / 3 == wid);
    else part = (lo <= tw_hi);
    if (MODE == M_FOX) {
      if (part && !wdone) { const float bound = ubq - CBs[63]; if (__all((bound - m_run) < -140.0f)) wdone = true; }
      part = part && !wdone;
    }
    if (part) {
      f32x16 s0, s1;
#pragma unroll
      for (int r = 0; r < 16; ++r) { s0[r] = 0.f; s1[r] = 0.f; }
#pragma unroll
      for (int d0 = 0; d0 < 4; ++d0) {
        const bf16x8 k0 = *(const bf16x8*)(Ks + r32 * 144 + d0 * 32 + hi * 16);
        const bf16x8 k1 = *(const bf16x8*)(Ks + (32 + r32) * 144 + d0 * 32 + hi * 16);
        s0 = MFMA32(k0, qf[d0], s0); s1 = MFMA32(k1, qf[d0], s1);
      }
      bool row_ok = true;
      if (MODE == M_FOX) {
#pragma unroll
        for (int g = 0; g < 4; ++g) {
          const float4 c0 = *(const float4*)(CBs + 8 * g + 4 * hi); const float4 c1 = *(const float4*)(CBs + 32 + 8 * g + 4 * hi);
          s0[4 * g + 0] -= c0.x; s0[4 * g + 1] -= c0.y; s0[4 * g + 2] -= c0.z; s0[4 * g + 3] -= c0.w;
          s1[4 * g + 0] -= c1.x; s1[4 * g + 1] -= c1.y; s1[4 * g + 2] -= c1.z; s1[4 * g + 3] -= c1.w;
        }
      }
      if (MODE == M_FOX || MODE == M_MOBA) {
        if (MODE == M_MOBA) row_ok = (selmask >> (lo >> 8)) & 1u;
        if (lo + 63 > tw_lo) {
#pragma unroll
          for (int r = 0; r < 16; ++r) {
            const int kp = lo + crow(r, hi);
            if (kp > tq) s0[r] = -INFINITY;
            if (kp + 32 > tq) s1[r] = -INFINITY;
          }
        }
      }
      if (MODE == M_DSA) {
        const u64 w = mrow[(size_t)j * 32];
#if SELFCHECK == 2
        const unsigned wl = ((unsigned)w & ~1u) >> hi, wh = (unsigned)(w >> 32) >> hi;
#else
        const unsigned wl = (unsigned)w >> hi, wh = (unsigned)(w >> 32) >> hi;
#endif
#pragma unroll
        for (int r = 0; r < 16; ++r) {
          const int e = r & 3, g = r >> 2;
          const unsigned word = (e < 2) ? wl : wh;
          const int bit = 16 * (e & 1) + 2 * g;
          const unsigned k0_ = (unsigned)__builtin_amdgcn_sbfe((int)word, bit, 1), k1_ = (unsigned)__builtin_amdgcn_sbfe((int)word, bit + 8, 1);
          s0[r] = __uint_as_float((__float_as_uint(s0[r]) & k0_) | (0xFF800000u & ~k0_));
          s1[r] = __uint_as_float((__float_as_uint(s1[r]) & k1_) | (0xFF800000u & ~k1_));
        }
      }
      if (MODE == M_DIL) {
        const unsigned lim = (unsigned)min(128 * rs, tq);
        const int dq = tq - lo - rs * 4 * hi;
#pragma unroll
        for (int r = 0; r < 16; ++r) {
          const int c_r = (r & 3) + 8 * (r >> 2);
          const int d0 = dq - rs * c_r, d1 = d0 - 32 * rs;
          if ((unsigned)d0 > lim) s0[r] = -INFINITY;
          if ((unsigned)d1 > lim) s1[r] = -INFINITY;
        }
      }
#define MX3(a_, b_, c_) __builtin_fmaxf(__builtin_fmaxf((a_), (b_)), (c_))
      float mxa = MX3(s0[0], s0[1], s1[0]), mxb = MX3(s0[2], s0[3], s1[1]); mxa = MX3(mxa, s1[2], s1[3]);
#pragma unroll
      for (int r = 4; r < 16; r += 4) { mxa = MX3(mxa, s0[r], s0[r + 1]); mxb = MX3(mxb, s0[r + 2], s0[r + 3]); mxa = MX3(mxa, s1[r], s1[r + 1]); mxb = MX3(mxb, s1[r + 2], s1[r + 3]); }
#undef MX3
      float mx = fmaxf(mxa, mxb);
      if (MODE == M_MOBA) mx = row_ok ? mx : -INFINITY;
      mx = fmaxf(mx, __shfl_xor(mx, 32));
      const float m_new = fmaxf(m_run, mx);
      const float m_safe = (m_new == -INFINITY) ? 0.f : m_new;
      const float alpha = ex2(m_run - m_safe);
      const float m_exp = (MODE == M_MOBA && !row_ok) ? INFINITY : m_safe;
      float sum = 0.f;
#pragma unroll
      for (int r = 0; r < 16; ++r) { s0[r] = ex2(s0[r] - m_exp); s1[r] = ex2(s1[r] - m_exp); sum += s0[r] + s1[r]; }
      l_run = l_run * alpha + sum; m_run = m_new;
      if (__any(alpha != 1.0f)) {
        if (hi == 0) AL[r32] = alpha;
        __builtin_amdgcn_fence(__ATOMIC_RELEASE, "wavefront");
#pragma unroll
        for (int g = 0; g < 4; ++g) {
          const float4 a4 = *(const float4*)(AL + 8 * g + 4 * hi);
          o0[4 * g + 0] *= a4.x; o0[4 * g + 1] *= a4.y; o0[4 * g + 2] *= a4.z; o0[4 * g + 3] *= a4.w;
          o1[4 * g + 0] *= a4.x; o1[4 * g + 1] *= a4.y; o1[4 * g + 2] *= a4.z; o1[4 * g + 3] *= a4.w;
        }
      }
      bf16x8 pa[4];
      {
        uint4 u;
        u.x = pack2(s0[0], s0[1]); u.y = pack2(s0[2], s0[3]); u.z = pack2(s0[4], s0[5]); u.w = pack2(s0[6], s0[7]); pa[0] = __builtin_bit_cast(bf16x8, u);
        u.x = pack2(s0[8], s0[9]); u.y = pack2(s0[10], s0[11]); u.z = pack2(s0[12], s0[13]); u.w = pack2(s0[14], s0[15]); pa[1] = __builtin_bit_cast(bf16x8, u);
        u.x = pack2(s1[0], s1[1]); u.y = pack2(s1[2], s1[3]); u.z = pack2(s1[4], s1[5]); u.w = pack2(s1[6], s1[7]); pa[2] = __builtin_bit_cast(bf16x8, u);
        u.x = pack2(s1[8], s1[9]); u.y = pack2(s1[10], s1[11]); u.z = pack2(s1[12], s1[13]); u.w = pack2(s1[14], s1[15]); pa[3] = __builtin_bit_cast(bf16x8, u);
      }
      {
        const int i16 = lane & 15, qq = i16 >> 2, pp = i16 & 3, blk = (lane >> 4) & 1;
        const lds_cptr vbase = (lds_cptr)Vs + (4 * hi + qq) * 144 + blk * 32 + pp * 8;
#pragma unroll
        for (int ks = 0; ks < 4; ++ks) {
#pragma unroll
          for (int dh = 0; dh < 2; ++dh) {
            const s16x4 lo4 = vtr(vbase + (ks * 16) * 144 + dh * 64);
            const s16x4 hi4 = vtr(vbase + (ks * 16 + 8) * 144 + dh * 64);
            const bf16x8 vf = __builtin_shufflevector(lo4, hi4, 0, 1, 2, 3, 4, 5, 6, 7);
            if (dh == 0) o0 = MFMA32(pa[ks], vf, o0); else o1 = MFMA32(pa[ks], vf, o1);
          }
        }
      }
    }
  }
  {
    const float l_tot = l_run + __shfl_xor(l_run, 32);
    if (hi == 0) AL[r32] = 1.0f / l_tot;
    __builtin_amdgcn_fence(__ATOMIC_RELEASE, "wavefront");
#pragma unroll
    for (int g = 0; g < 4; ++g) {
      const float4 a4 = *(const float4*)(AL + 8 * g + 4 * hi);
      const float av[4] = {a4.x, a4.y, a4.z, a4.w};
#pragma unroll
      for (int e = 0; e < 4; ++e) {
        const int qr = wid * 32 + 8 * g + 4 * hi + e;
        const int tqr = (MODE == M_DIL) ? ((it * 32 + (qr - wid * 32)) * 16 + res16 + 4 * wid) : (qt * 128 + qr);
        u16* dst = O + (rowbase + tqr) * kD + grp * 256 + h * 64 + r32;
        dst[0] = f2bf(o0[4 * g + e] * av[e]);
        dst[32] = f2bf(o1[4 * g + e] * av[e]);
      }
    }
  }
  __syncthreads();
}

#undef PREFETCH
#undef TILE_OF

#if SELFCHECK
DI float bf2f(u16 v) { return __uint_as_float((unsigned)v << 16); }
DI void sc_flag(const Params& p, unsigned idx) { atomicOr((unsigned*)(wsp(p) + OFF_CNT) + 200, 1u << idx); }
DI float blk_max(float v, float* red) {
  const int tid = tidx();
  red[tid] = v; __syncthreads();
  float m = -INFINITY; for (int i = 0; i < 256; ++i) m = fmaxf(m, red[i]);
  __syncthreads(); return m;
}
DI void check_attn(const Params& p, const int mode, const int b, const int t, const int h, char* lds) {
  const int tid = tidx();
  float* sc = (float*)lds; float* red = (float*)(lds + 32768); float* acc4 = (float*)(lds + 32768 + 1024); float* l4 = (float*)(lds + 32768 + 1024 + 1024);
  char* ws = wsp(p);
  const u16* QKV = (const u16*)(ws + OFF_QKV); const u16* O = (const u16*)(ws + OFF_O);
  const int qcol = mode * 768 + h * 64, kcol = qcol + 256, vcol = qcol + 512;
  const size_t rb = (size_t)b * kT;
  unsigned allowed = 0xffffffffu;
  if (mode == M_MOBA) {
    const int own = t >> 8; const u16* KMEAN = (const u16*)(ws + OFF_KMEAN);
    if (tid < 32) { float g = -INFINITY; if (tid < own) { g = 0.f; for (int d = 0; d < 64; ++d) g += bf2f(QKV[(rb + t) * kNQKV + qcol + d]) * bf2f(KMEAN[(((size_t)b * 32 + tid) * 4 + h) * 64 + d]); } red[tid] = g; }
    __syncthreads();
    allowed = 0;
    for (int round = 0; round < 3; ++round) { float best = -INFINITY; int bi = -1; for (int n = 0; n < own; ++n) if (!((allowed >> n) & 1u) && red[n] > best) { best = red[n]; bi = n; } if (bi >= 0) allowed |= 1u << bi; }
    allowed |= 1u << own;
    __syncthreads();
  }
  const int n = (mode == M_DIL) ? 387 : (t + 1);
  float lmax = -INFINITY;
  for (int e = tid; e < n; e += 256) {
    int j = e; bool ok = true; float bias = 0.f;
    if (mode == M_DIL) { const int pi = e / 129, i = e % 129; const int r = (pi == 0) ? 1 : (pi == 1 ? 4 : 16); j = t - i * r; ok = (j >= 0); }
    float sv = -INFINITY;
    if (ok) {
      if (mode == M_FOX) bias = -((const float*)(ws + OFF_CB))[(size_t)(b * 4 + h) * kT + j];
      if (mode == M_DSA) { const u64 w = ((const u64*)(ws + OFF_MASK))[((size_t)(b * 256 + (t >> 5)) * 128 + (j >> 6)) * 32 + (t & 31)]; const int kk = j & 63; ok = (w >> (16 * (kk & 3) + (kk >> 2))) & 1ull; }
      if (mode == M_MOBA) ok = (allowed >> (j >> 8)) & 1u;
      if (ok) { float d_ = 0.f; for (int d = 0; d < 64; ++d) d_ += bf2f(QKV[(rb + t) * kNQKV + qcol + d]) * bf2f(QKV[(rb + j) * kNQKV + kcol + d]); sv = d_ + bias; }
    }
    sc[e] = sv; lmax = fmaxf(lmax, sv);
  }
  __syncthreads();
  const float m = blk_max(lmax, red);
  const int d = tid & 63, part = tid >> 6;
  float acc = 0.f, l = 0.f;
  for (int e = part; e < n; e += 4) {
    const float sv = sc[e];
    if (sv > -INFINITY) {
      int j = e; if (mode == M_DIL) { const int pi = e / 129, i = e % 129; const int r = (pi == 0) ? 1 : (pi == 1 ? 4 : 16); j = t - i * r; }
      const float pe = exp2f(sv - m); acc += pe * bf2f(QKV[(rb + j) * kNQKV + vcol + d]); l += pe;
    }
  }
  acc4[tid] = acc; if (d == 0) l4[part] = l;
  __syncthreads();
  if (tid < 64) {
    const float o = (acc4[tid] + acc4[tid + 64] + acc4[tid + 128] + acc4[tid + 192]) / (l4[0] + l4[1] + l4[2] + l4[3]);
    const float got = bf2f(O[(rb + t) * kD + mode * 256 + h * 64 + tid]);
    if (!(fabsf(got - o) <= 0.003f + 0.012f * fabsf(o))) sc_flag(p, mode);
  }
  __syncthreads();
}
DI void check_select(const Params& p, const int b, const int t, char* lds) {
  const int tid = tidx(); char* ws = wsp(p);
  float* sc = (float*)lds; unsigned* cnts = (unsigned*)(lds + 32768);
  const u16* IDXQ = (const u16*)(ws + OFF_IDXQ); const u16* IDXK = (const u16*)(ws + OFF_IDXK); const float* WI = (const float*)(ws + OFF_WI);
  const size_t rb = (size_t)b * kT;
  if (tid < 2) cnts[tid] = 0;
  for (int j = tid; j <= t; j += 256) {
    float tot = 0.f;
    for (int hh = 0; hh < 8; ++hh) { float d_ = 0.f; for (int e = 0; e < 32; ++e) d_ += bf2f(IDXQ[(rb + t) * 256 + hh * 32 + e]) * bf2f(IDXK[(rb + j) * 32 + e]); tot += WI[(rb + t) * 8 + hh] * fmaxf(d_, 0.f); }
    sc[j] = tot + 0.0f;
  }
  __syncthreads();
  const int jend = (t | 127);
  unsigned mism = 0, total = 0;
  for (int j = tid; j <= jend; j += 256) {
    bool sel = false;
    if (j <= t) { const float sj = sc[j]; int rank = 0; for (int i = 0; i <= t; ++i) { const float si = sc[i]; rank += (si > sj || (si == sj && i < j)) ? 1 : 0; } sel = rank < 256; }
    const u64 w = ((const u64*)(ws + OFF_MASK))[((size_t)(b * 256 + (t >> 5)) * 128 + (j >> 6)) * 32 + (t & 31)]; const int kk = j & 63;
    const bool got = (w >> (16 * (kk & 3) + (kk >> 2))) & 1ull;
    if (got) ++total; if (got != sel) ++mism; if (got && j > t) mism += 100;
  }
  atomicAdd(&cnts[0], mism); atomicAdd(&cnts[1], total);
  __syncthreads();
  if (tid == 0) { const unsigned want = (t + 1 < 256) ? (unsigned)(t + 1) : 256u; if (cnts[1] != want) sc_flag(p, 8); if (cnts[1] > want) sc_flag(p, 9); if (cnts[1] < want) sc_flag(p, 10); if (cnts[1] > want + 8) sc_flag(p, 11); if (cnts[1] + 8 < want) sc_flag(p, 12); if (cnts[1] > want + 64) sc_flag(p, 13); if (cnts[1] + 64 < want) sc_flag(p, 14); if (cnts[0] > 4) sc_flag(p, 4); if (cnts[0] > 12) sc_flag(p, 5); if (cnts[0] > 40) sc_flag(p, 6); if (cnts[0] > 200) sc_flag(p, 7); }
  __syncthreads();
}
DI void check_inproj(const Params& p, const int m, char* lds) {
  const int tid = tidx(); char* ws = wsp(p);
  float* raw = (float*)lds; float* xs = (float*)(lds + 16384);
  for (int k = tid; k < kD; k += 256) xs[k] = p.x[(size_t)m * kD + k];
  __syncthreads();
  for (int c = tid; c < kDIN; c += 256) { float a = 0.f; for (int k = 0; k < kD; ++k) a += xs[k] * p.w_in[(size_t)k * kDIN + c]; raw[c] = a; }
  __syncthreads();
  const int t = m & (kT - 1);
  const u16* QKV = (const u16*)(ws + OFF_QKV);
  bool bad = false;
  for (int c = tid; c < kDIN; c += 256) {
    float expect, got;
    int kind, off, mybase;
    bool scale = false;
    if (c < 256) { kind = 0; off = c; mybase = 0; scale = true; }
    else if (c < 768) { kind = 0; off = c - 256; mybase = 256; }
    else if (c < 772) { kind = 2; off = c - 768; mybase = 0; }
    else if (c < 1028) { kind = 1; off = c - 772; mybase = 768; scale = true; }
    else if (c < 1284) { kind = 1; off = c - 1028; mybase = 1024; }
    else if (c < 1540) { kind = 0; off = c - 1284; mybase = 1280; }
    else if (c < 1796) { kind = 3; off = c - 1540; mybase = 0; }
    else if (c < 1828) { kind = 4; off = c - 1796; mybase = 0; }
    else if (c < 1836) { kind = 5; off = c - 1828; mybase = 0; }
    else if (c < 2092) { kind = 1; off = c - 1836; mybase = 1536; scale = true; }
    else if (c < 2348) { kind = 1; off = c - 2092; mybase = 1792; }
    else if (c < 2604) { kind = 0; off = c - 2348; mybase = 2048; }
    else if (c < 2860) { kind = 1; off = c - 2604; mybase = 2304; scale = true; }
    else if (c < 3116) { kind = 1; off = c - 2860; mybase = 2560; }
    else { kind = 0; off = c - 3116; mybase = 2816; }
    if (kind == 0) { expect = raw[c]; if (scale) expect *= kQScale; got = bf2f(QKV[(size_t)m * kNQKV + mybase + off]); }
    else if (kind == 1) {
      const int dh = off & 63, i = dh & 31; const int cb_ = c - dh; const float x1 = raw[cb_ + i], x2 = raw[cb_ + i + 32];
      const float ang = (float)t * powf(10000.0f, -(float)i / 32.0f); const float cs = cosf(ang), sn = sinf(ang);
      expect = (dh < 32) ? (x1 * cs - x2 * sn) : (x2 * cs + x1 * sn); if (scale) expect *= kQScale;
      got = bf2f(QKV[(size_t)m * kNQKV + mybase + off]);
    } else if (kind == 2) { const float z = raw[c] + p.b_f[off]; expect = -logf(1.0f + expf(-z)); got = ((const float*)(ws + OFF_LOGF))[(size_t)m * 4 + off]; }
    else if (kind == 3 || kind == 4) {
      const int dh = off & 31, i = dh & 15; const int cb_ = c - dh; const float x1 = raw[cb_ + i], x2 = raw[cb_ + i + 16];
      const float ang = (float)t * powf(10000.0f, -(float)i / 16.0f); const float cs = cosf(ang), sn = sinf(ang);
      expect = (dh < 16) ? (x1 * cs - x2 * sn) : (x2 * cs + x1 * sn);
      got = (kind == 3) ? bf2f(((const u16*)(ws + OFF_IDXQ))[(size_t)m * 256 + off]) : bf2f(((const u16*)(ws + OFF_IDXK))[(size_t)m * 32 + off]);
    } else { expect = raw[c]; got = ((const float*)(ws + OFF_WI))[(size_t)m * 8 + off]; }
    if (!(fabsf(got - expect) <= 0.03f + 0.02f * fabsf(expect))) bad = true;
  }
  if (bad) sc_flag(p, 7);
  __syncthreads();
}
DI void check_misc(const Params& p, const int idx) {
  const int tid = tidx(); char* ws = wsp(p);
  if (idx < 16) {
    if (tid == 0) {
      const float* LOGF = (const float*)(ws + OFF_LOGF); const float* CB = (const float*)(ws + OFF_CB);
      double run = 0.0; bool bad = false;
      for (int t = 0; t < kT; ++t) { run += (double)LOGF[((size_t)(idx >> 2) * kT + t) * 4 + (idx & 3)]; if ((t & 1023) == 1023 || t == 0 || t == 77) { const double want = run * 1.4426950408889634; if (!(fabs((double)CB[(size_t)idx * kT + t] - want) <= 1e-3 + 1e-4 * fabs(want))) bad = true; } }
      if (bad) sc_flag(p, 6);
    }
  } else {
    const int k = idx - 16; const int b = k >> 5, blk = k & 31;
    const u16* QKV = (const u16*)(ws + OFF_QKV); const u16* KMEAN = (const u16*)(ws + OFF_KMEAN);
    float s_ = 0.f; for (int i = 0; i < 256; ++i) s_ += bf2f(QKV[((size_t)b * kT + blk * 256 + i) * kNQKV + 2560 + tid]);
    const float want = s_ / 256.0f; const float got = bf2f(KMEAN[(((size_t)b * 32 + blk) * 4 + (tid >> 6)) * 64 + (tid & 63)]);
    if (!(fabsf(got - want) <= 0.005f + 0.01f * fabsf(want))) sc_flag(p, 5);
  }
}
DI unsigned sc_rng(unsigned x) { x ^= x >> 16; x *= 0x7feb352du; x ^= x >> 15; x *= 0x846ca68bu; x ^= x >> 16; return x; }
DI void selfcheck_phase(const Params& p, char* lds) {
  for (int i = blockIdx.x; i < 848; i += gridDim.x) {
    const unsigned r = sc_rng(i * 2654435761u + 12345u);
    if (i < 512) {
      const int mode = i >> 7, k = i & 127; int t;
      if (k < 8) t = k; else if (k < 16) t = 248 + k; else if (k < 24) t = 8184 + (k - 16); else if (k < 40) t = ((k - 24) * 512 + 255 + (k & 1)) & 8191; else t = r & 8191;
      check_attn(p, mode, (r >> 13) & 3, t, (r >> 15) & 3, lds);
    } else if (i < 640) {
      const int k = i - 512; int t;
      if (k < 8) t = 250 + k; else if (k < 16) t = 8184 + (k - 8); else if (k < 20) t = k - 16; else t = r & 8191;
      check_select(p, (r >> 13) & 3, t, lds);
    } else if (i < 704) {
      const int k = i - 640; const int m = (k < 4) ? k : (k < 8 ? kM - 1 - (k - 4) : (int)(r & (kM - 1)));
      check_inproj(p, m, lds);
    } else check_misc(p, i - 704);
  }
}
#endif

#define XB_TMO      128
#define XB_XCNT(j)  (256  + 64 * (j))
#define XB_XSUB(j)  (1280 + 64 * (j))
#define XB_XGEN(j)  (2304 + 64 * (j))
#define XB_TOP      3328
#define XB_TOPGEN   3392
#define XCD_BAR_WORDS 3456
#define XB_SPIN_CAP (1u << 22)
#define LAS __attribute__((address_space(3)))
DI unsigned xb_ld(unsigned* p) { return __hip_atomic_load(p, __ATOMIC_RELAXED, __HIP_MEMORY_SCOPE_AGENT); }
DI unsigned xb_add(unsigned* p, unsigned v) { return __hip_atomic_fetch_add(p, v, __ATOMIC_RELAXED, __HIP_MEMORY_SCOPE_AGENT); }
DI unsigned xb_xcc_id() { return (unsigned)__builtin_amdgcn_s_getreg((3 << 11) | 20) & 0xFu; }
#define XB_SPIN(cond, bar) do { unsigned _sp = 0; while (cond) { __builtin_amdgcn_s_sleep(1); \
    if ((++_sp & 255u) == 0u) { if (xb_ld(&(bar)[XB_TMO])) break; if (_sp > XB_SPIN_CAP) { atomicAdd(&(bar)[XB_TMO], 1u); break; } } } } while (0)
struct XcdBarrier { unsigned* bar; unsigned x; volatile LAS unsigned* st; };
DI XcdBarrier xcd_barrier_post(unsigned* bar, volatile LAS unsigned* st) {
  XcdBarrier b; b.bar = bar; b.x = xb_xcc_id(); b.st = st;
  if (threadIdx.x == 0) (void)xb_add(&bar[XB_XCNT(b.x)], 1u);
  return b;
}
DI void xcd_barrier_complete(unsigned* bar, unsigned x, unsigned& nloc, unsigned& nx) {
  const unsigned G = gridDim.x * gridDim.y * gridDim.z;
  unsigned sum, cnt, mine, sp = 0u;
  for (;;) {
    sum = 0u; cnt = 0u; mine = 0u;
#pragma unroll
    for (unsigned j = 0; j < 16; ++j) { const unsigned c = xb_ld(&bar[XB_XCNT(j)]); sum += c; cnt += (c > 0u) ? 1u : 0u; mine = (j == x) ? c : mine; }
    if (sum == G) break;
    __builtin_amdgcn_s_sleep(1);
    if ((++sp & 255u) == 0u) { if (xb_ld(&bar[XB_TMO])) break; if (sp > XB_SPIN_CAP) { atomicAdd(&bar[XB_TMO], 1u); break; } }
  }
  nloc = mine > 0u ? mine : 1u; nx = cnt > 0u ? cnt : 1u;
}
DI void xcd_barrier(const XcdBarrier& b) {
  asm volatile("s_waitcnt vmcnt(0)" ::: "memory");
  __syncthreads();
  if (threadIdx.x == 0) {
    unsigned* bar = b.bar;
    __builtin_amdgcn_s_waitcnt(0);
    unsigned nloc = b.st[0], nx = b.st[1];
    if (nloc == 0u) { xcd_barrier_complete(bar, b.x, nloc, nx); b.st[0] = nloc; b.st[1] = nx; }
    const unsigned old = xb_add(&bar[XB_XSUB(b.x)], 1u);
    const unsigned gen = old / nloc;
    if (old + 1u == (gen + 1u) * nloc) {
      __builtin_amdgcn_fence(__ATOMIC_RELEASE, "agent");
      asm volatile("s_waitcnt vmcnt(0)" ::: "memory");
      const unsigned og = xb_add(&bar[XB_TOP], 1u);
      const unsigned tg = og / nx;
      if (og + 1u == (tg + 1u) * nx) xb_add(&bar[XB_TOPGEN], 1u);
      else XB_SPIN(xb_ld(&bar[XB_TOPGEN]) == tg, bar);
      __builtin_amdgcn_fence(__ATOMIC_ACQUIRE, "agent");
      xb_add(&bar[XB_XGEN(b.x)], 1u);
      asm volatile("s_waitcnt vmcnt(0)" ::: "memory");
    } else {
      XB_SPIN(xb_ld(&bar[XB_XGEN(b.x)]) == gen, bar);
      __builtin_amdgcn_fence(__ATOMIC_ACQUIRE, "agent");
      asm volatile("s_waitcnt vmcnt(0)" ::: "memory");
    }
  }
  __syncthreads();
}
DI int next_item(unsigned* cnt, int* slot) {
  __syncthreads();
  if (threadIdx.x == 0) *slot = (int)atomicAdd(cnt, 1u);
  __syncthreads();
  return __builtin_amdgcn_readfirstlane(*slot);
}

__global__ void __launch_bounds__(256, 2) mega(Params p_in) {
  extern __shared__ __attribute__((aligned(16))) char lds[];
  int* slot = (int*)(lds + 65536 + 10240);
  volatile LAS unsigned* xst = (volatile LAS unsigned*)(LAS char*)(lds + 65536 + 10240 + 16);
  XcdBarrier xbar;
  const unsigned xcc = xb_xcc_id() & 7u;
  if (p_in.coop) {
    if (threadIdx.x == 0) { xst[0] = 0u; xst[1] = 0u; xst[2] = 0u; xst[3] = 0u; }
    __syncthreads();
    xbar = xcd_barrier_post((unsigned*)(p_in.ws + OFF_BAR), xst);
  }
  char* ws; unsigned* cnt;
  const Params& p = p_in;
  for (int ph = p_in.phase_begin; ph < p_in.phase_end; ++ph) {
    { size_t z = 0; asm volatile("" : "+s"(z)); ws = p_in.ws + z; }
    cnt = (unsigned*)(ws + OFF_CNT);
    for (int rep = 0; rep < 2; ++rep) {
    if (rep == 1) { if (ph == 0 || !((REPEAT_MASK >> ((ph - 1) & 7)) & 1)) break; if (p_in.coop) xcd_barrier(xbar); cnt += 1024; }
    if (ph == 0) {
      if (HAS(8)) init_phase(p, lds);
    } else {
      const int l = (ph - 1) >> 3, s = (ph - 1) & 7;
      if (HAS(0) && s == 0) {
        gemm_phase<EPI_INPROJ>(p, (const u16*)(ws + OFF_WIN) + (size_t)l * kNPAD * kD, (const u16*)(ws + OFF_XB), kNPAD, kD, l, lds, cnt + 256 + ph * 8, slot, xcc);
      } else if (HAS(1) && s == 1) {
        unsigned* c = cnt + l;
        constexpr int nitems = 16 + 128 + kM / 4;
        for (int i = next_item(c, slot); i < nitems; i = next_item(c, slot)) {
          if (i < 16) cumsum_item(p, i, lds);
          else if (i < 144) kmean_item(p, i - 16);
          else { const int k = i - 144; select_item(p, k & 3, 4 * (2047 - (k >> 2)), lds); }
        }
      } else if (HAS(2) && s == 2) {
        for (int pass = 0; pass < 2; ++pass) {
#pragma unroll 1
          for (int mode = 0; mode < 4; ++mode) {
            XQ q; q.c = cnt + 600 + (l * 4 + mode) * 8; q.step = pass; q.xcc = xcc;
            const int max_step = pass ? 8 : 1;
            for (int v = xq_pull(q, 128, slot, max_step); v >= 0; v = xq_pull(q, 128, slot, max_step)) {
              const int xq = v >> 7, tk = v & 127; const int bh = 2 * xq + (tk & 1), j = tk >> 1;
              if (mode == 0) attn_item<M_FOX>(p, bh >> 2, bh & 3, 63 - j, lds);
              else if (mode == 1) attn_item<M_DSA>(p, bh >> 2, bh & 3, 63 - j, lds);
              else if (mode == 2) attn_item<M_MOBA>(p, bh >> 2, bh & 3, 63 - j, lds);
              else attn_item<M_DIL>(p, bh >> 2, bh & 3, j, lds);
            }
          }
        }
      } else if (HAS(3) && s == 3) {
        gemm_phase<EPI_RESID>(p, (const u16*)(ws + OFF_WO) + (size_t)l * kD * kD, (const u16*)(ws + OFF_O), kD, kD, l, lds, cnt + 256 + ph * 8, slot, xcc);
      } else if (HAS(4) && s == 4) {
        ln_phase(p, p.ln1_g + l * kD, p.ln1_b + l * kD, false);
      } else if (HAS(5) && s == 5) {
        gemm_phase<EPI_RELU2>(p, (const u16*)(ws + OFF_WUP) + (size_t)l * kDFF * kD, (const u16*)(ws + OFF_XB), kDFF, kD, l, lds, cnt + 256 + ph * 8, slot, xcc);
      } else if (HAS(6) && s == 6) {
        gemm_phase<EPI_RESID>(p, (const u16*)(ws + OFF_WDN) + (size_t)l * kD * kDFF, (const u16*)(ws + OFF_QKV), kD, kDFF, l, lds, cnt + 256 + ph * 8, slot, xcc);
      } else if (HAS(7)) {
        ln_phase(p, p.ln2_g + l * kD, p.ln2_b + l * kD, l == kDepth - 1);
      }
    }
    }
    if (p_in.coop && ph + 1 < p_in.phase_end) { if (p_in.pad == 0x5eed) cg::this_grid().sync(); else xcd_barrier(xbar); }
  }
}

#if SELFCHECK
__global__ void __launch_bounds__(256) selfcheck_kernel(Params p) {
  extern __shared__ __attribute__((aligned(16))) char lds[];
  selfcheck_phase(p, lds);
}
__global__ void poison_kernel(Params p) {
  if (blockIdx.x == 0 && threadIdx.x == 0) {
    const unsigned f = ((volatile unsigned*)(p.ws + OFF_CNT))[200];
    if (f) { const int top = 31 - __clz((int)f); p.out[0] = 1024.0f * (float)(1 << top); p.out[1] = (float)f; }
  }
}
#endif

extern "C" void kernel_launch(void* const* d_in, const int* in_sizes, int n_in, void* d_out, int out_size, void* d_ws, size_t ws_size, hipStream_t stream) {
  (void)in_sizes; (void)n_in; (void)out_size;
  if (ws_size < WS_TOTAL) { fprintf(stderr, "workspace too small: %zu < %zu\n", ws_size, (size_t)WS_TOTAL); return; }
  Params p{};
  p.x = (const float*)d_in[0]; p.w_in = (const float*)d_in[1]; p.b_f = (const float*)d_in[2]; p.w_o = (const float*)d_in[3];
  p.ln1_g = (const float*)d_in[4]; p.ln1_b = (const float*)d_in[5]; p.w_up = (const float*)d_in[6]; p.w_down = (const float*)d_in[7];
  p.ln2_g = (const float*)d_in[8]; p.ln2_b = (const float*)d_in[9];
  p.out = (float*)d_out; p.ws = (char*)d_ws; p.pad = 0;
  static int grid_blocks = 0;
  if (!grid_blocks) {
    hipFuncSetAttribute((const void*)mega, hipFuncAttributeMaxDynamicSharedMemorySize, LDS_BYTES);
    int dev = 0, cus = 0, per_cu = 0;
    hipGetDevice(&dev);
    hipDeviceGetAttribute(&cus, hipDeviceAttributeMultiprocessorCount, dev);
    hipOccupancyMaxActiveBlocksPerMultiprocessor(&per_cu, (const void*)mega, 256, LDS_BYTES);
    if (per_cu > 2) per_cu = 2;
    if (per_cu < 1) per_cu = 1;
    grid_blocks = cus * per_cu;
  }
  (void)hipMemsetAsync((char*)d_ws + OFF_CNT, 0, SZ_CNT + SZ_BAR, stream);
  constexpr int nphases = 1 + 8 * kDepth;
#if SELFCHECK
  {
    hipFuncSetAttribute((const void*)selfcheck_kernel, hipFuncAttributeMaxDynamicSharedMemorySize, LDS_BYTES);
    Params pa = p; pa.phase_begin = 0; pa.phase_end = 4; pa.coop = 1;
    void* a1[] = {&pa};
    hipLaunchCooperativeKernel((const void*)mega, dim3(grid_blocks), dim3(256), a1, LDS_BYTES, stream);
    hipLaunchKernelGGL(selfcheck_kernel, dim3(grid_blocks), dim3(256), LDS_BYTES, stream, p);
    hipMemsetAsync((char*)d_ws + OFF_BAR, 0, SZ_BAR, stream);
    Params pb = p; pb.phase_begin = 4; pb.phase_end = nphases; pb.coop = 1;
    void* a2[] = {&pb};
    hipLaunchCooperativeKernel((const void*)mega, dim3(grid_blocks), dim3(256), a2, LDS_BYTES, stream);
    hipLaunchKernelGGL(poison_kernel, dim3(1), dim3(64), 0, stream, p);
  }
#elif ONE_LAUNCH
  p.phase_begin = 0; p.phase_end = nphases; p.coop = 1;
  void* args[] = {&p};
  hipError_t e = hipLaunchCooperativeKernel((const void*)mega, dim3(grid_blocks), dim3(256), args, LDS_BYTES, stream);
  if (e != hipSuccess) fprintf(stderr, "cooperative launch failed: %s (grid %d)\n", hipGetErrorString(e), grid_blocks);
#else
  for (int ph = 0; ph < nphases; ++ph) {
    p.phase_begin = ph; p.phase_end = ph + 1; p.coop = 0;
    hipLaunchKernelGGL(mega, dim3(grid_blocks), dim3(256), LDS_BYTES, stream, p);
  }
#endif
}
```

```cpp
#include <hip/hip_runtime.h>
#include <hip/hip_cooperative_groups.h>
#include <cstdio>
#include <cstdint>
namespace cg = cooperative_groups;

#ifndef ONE_LAUNCH
#define ONE_LAUNCH 1
#endif

#ifndef SELFCHECK
#define SELFCHECK 0
#endif
#ifndef REPEAT_MASK
#define REPEAT_MASK 0
#endif
#ifndef PHASE_MASK
#define PHASE_MASK 0x1ff
#endif
#define HAS(s_) ((PHASE_MASK >> (s_)) & 1)
#define DI __device__ __forceinline__
typedef unsigned short u16;
typedef unsigned long long u64;
typedef __attribute__((ext_vector_type(8))) short bf16x8;
typedef __attribute__((ext_vector_type(4))) short s16x4;
typedef __attribute__((ext_vector_type(16))) float f32x16;
typedef __attribute__((ext_vector_type(4))) float f32x4;
typedef __attribute__((ext_vector_type(2))) float f32x2;
typedef __attribute__((ext_vector_type(2))) __bf16 bf16x2_t;
typedef __attribute__((address_space(3))) const char* lds_cptr;
typedef short v4i16_t __attribute__((ext_vector_type(4)));
typedef __attribute__((ext_vector_type(4))) unsigned u32x4;

#define MFMA32(a, b, c) __builtin_amdgcn_mfma_f32_32x32x16_bf16((a), (b), (c), 0, 0, 0)
#define MFMA16(a, b, c) __builtin_amdgcn_mfma_f32_16x16x32_bf16((a), (b), (c), 0, 0, 0)

constexpr int kB = 4, kT = 8192, kD = 1024, kM = kB * kT, kDepth = 4;
constexpr int kNQKV = 3072, kNPAD = 3456, kDFF = 4096, kDIN = 3372;
constexpr float kAlpha = 1.6817928305074290f;
constexpr float kLog2e = 1.4426950408889634f;
constexpr float kQScale = 0.125f * 1.4426950408889634f;
constexpr float kLnEps = 1e-5f;

constexpr size_t SZ_WIN = (size_t)kDepth * kNPAD * kD * 2;
constexpr size_t SZ_WO = (size_t)kDepth * kD * kD * 2;
constexpr size_t SZ_WUP = (size_t)kDepth * kDFF * kD * 2;
constexpr size_t SZ_WDN = SZ_WUP;
constexpr size_t SZ_XB = (size_t)kM * kD * 2;
constexpr size_t SZ_QKV = (size_t)kM * kNQKV * 2;
constexpr size_t SZ_O = (size_t)kM * kD * 2;
constexpr size_t SZ_MASK = (size_t)kM * 128 * 8;
constexpr size_t SZ_IDXQ = (size_t)kM * 256 * 2;
constexpr size_t SZ_IDXK = (size_t)kM * 32 * 2;
constexpr size_t SZ_WI = (size_t)kM * 8 * 4;
constexpr size_t SZ_LOGF = (size_t)kM * 4 * 4;
constexpr size_t SZ_CB = SZ_LOGF;
constexpr size_t SZ_KMEAN = (size_t)kB * 32 * 4 * 64 * 2;
constexpr size_t SZ_R32 = (size_t)kT * 32 * 2 * 4;
constexpr size_t SZ_R16 = (size_t)kT * 16 * 2 * 4;
constexpr size_t SZ_CNT = 8192;
constexpr size_t OFF_WIN = 0;
constexpr size_t OFF_WO = OFF_WIN + SZ_WIN;
constexpr size_t OFF_WUP = OFF_WO + SZ_WO;
constexpr size_t OFF_WDN = OFF_WUP + SZ_WUP;
constexpr size_t OFF_XB = OFF_WDN + SZ_WDN;
constexpr size_t OFF_QKV = OFF_XB + SZ_XB;
constexpr size_t OFF_O = OFF_QKV + SZ_QKV;
constexpr size_t OFF_MASK = OFF_O + SZ_O;
constexpr size_t OFF_IDXQ = OFF_MASK + SZ_MASK;
constexpr size_t OFF_IDXK = OFF_IDXQ + SZ_IDXQ;
constexpr size_t OFF_WI = OFF_IDXK + SZ_IDXK;
constexpr size_t OFF_LOGF = OFF_WI + SZ_WI;
constexpr size_t OFF_CB = OFF_LOGF + SZ_LOGF;
constexpr size_t OFF_KMEAN = OFF_CB + SZ_CB;
constexpr size_t OFF_R32 = OFF_KMEAN + SZ_KMEAN;
constexpr size_t OFF_R16 = OFF_R32 + SZ_R32;
constexpr size_t OFF_CNT = OFF_R16 + SZ_R16;
constexpr size_t OFF_BAR = OFF_CNT + SZ_CNT;
constexpr size_t SZ_BAR = 16384;
constexpr size_t OFF_KMAX = OFF_BAR + SZ_BAR;
constexpr size_t WS_TOTAL = OFF_KMAX + 256;

constexpr int LDS_BYTES = 65536 + 4096 + 2048 + 4096 + 64;

struct Params {
  const float* x; const float* w_in; const float* b_f; const float* w_o; const float* ln1_g; const float* ln1_b;
  const float* w_up; const float* w_down; const float* ln2_g; const float* ln2_b;
  float* out; char* ws;
  int phase_begin, phase_end, coop, pad;
};

DI unsigned pack2(float a, float b) { f32x2 v = {a, b}; bf16x2_t r = __builtin_convertvector(v, bf16x2_t); return __builtin_bit_cast(unsigned, r); }
DI u16 f2bf(float a) { return (u16)(pack2(a, 0.f) & 0xffffu); }
DI int crow(int r, int hi) { return (r & 3) + 8 * (r >> 2) + 4 * hi; }
DI s16x4 vtr(lds_cptr p) { return __builtin_bit_cast(s16x4, __builtin_amdgcn_ds_read_tr16_b64_v4i16((__attribute__((address_space(3))) v4i16_t*)p)); }
DI float ex2(float x) { return __builtin_amdgcn_exp2f(x); }
DI unsigned okey(float f) { unsigned u = __float_as_uint(f); return (u & 0x80000000u) ? ~u : (u | 0x80000000u); }

DI int tidx() { int t = threadIdx.x; asm volatile("" : "+v"(t)); return t; }
DI char* wsp(const Params& p) { size_t z = 0; asm volatile("" : "+s"(z)); return p.ws + z; }
DI float* outp(const Params& p) { size_t z = 0; asm volatile("" : "+s"(z)); return p.out + z; }

DI int refcol(int n) {
  if (n < 768) return n;
  if (n < 1536) return n + 4;
  if (n < 2304) return 1836 + (n - 1536);
  if (n < 3072) return 2604 + (n - 2304);
  if (n < 3328) return 1540 + (n - 3072);
  if (n < 3360) return 1796 + (n - 3328);
  if (n < 3368) return 1828 + (n - 3360);
  if (n < 3372) return 768 + (n - 3368);
  return -1;
}

DI void convert_tile(const float* __restrict__ src, int Nsrc, u16* __restrict__ dst, int K, int n0, int k0, bool remap, float* lds) {
  const int tid = tidx();
#pragma unroll 4
  for (int e = 0; e < 16; ++e) {
    const int idx = tid + 256 * e; const int k = idx >> 6, n = idx & 63;
    const int c = remap ? refcol(n0 + n) : (n0 + n);
    const float v = (c >= 0) ? src[(size_t)(k0 + k) * Nsrc + c] : 0.f;
    lds[k * 65 + n] = v;
  }
  __syncthreads();
#pragma unroll
  for (int e = 0; e < 2; ++e) {
    const int idx = tid + 256 * e; const int n = idx >> 3, ch = idx & 7;
    uint4 o;
    o.x = pack2(lds[(ch * 8 + 0) * 65 + n], lds[(ch * 8 + 1) * 65 + n]);
    o.y = pack2(lds[(ch * 8 + 2) * 65 + n], lds[(ch * 8 + 3) * 65 + n]);
    o.z = pack2(lds[(ch * 8 + 4) * 65 + n], lds[(ch * 8 + 5) * 65 + n]);
    o.w = pack2(lds[(ch * 8 + 6) * 65 + n], lds[(ch * 8 + 7) * 65 + n]);
    *(uint4*)(dst + (size_t)(n0 + n) * K + k0 + ch * 8) = o;
  }
  __syncthreads();
}

DI void init_phase(const Params& p, char* lds) {
  char* ws = wsp(p);
  constexpr int per_layer = 864 + 256 + 1024 + 1024;
  for (int idx = blockIdx.x; idx < per_layer * kDepth; idx += gridDim.x) {
    const int l = idx / per_layer; int r = idx % per_layer;
    if (r < 864) {
      convert_tile(p.w_in + (size_t)l * kD * kDIN, kDIN, (u16*)(ws + OFF_WIN) + (size_t)l * kNPAD * kD, kD, (r / 16) * 64, (r % 16) * 64, true, (float*)lds);
    } else if (r < 1120) {
      r -= 864;
      convert_tile(p.w_o + (size_t)l * kD * kD, kD, (u16*)(ws + OFF_WO) + (size_t)l * kD * kD, kD, (r / 16) * 64, (r % 16) * 64, false, (float*)lds);
    } else if (r < 2144) {
      r -= 1120;
      convert_tile(p.w_up + (size_t)l * kD * kDFF, kDFF, (u16*)(ws + OFF_WUP) + (size_t)l * kDFF * kD, kD, (r / 16) * 64, (r % 16) * 64, false, (float*)lds);
    } else {
      r -= 2144;
      convert_tile(p.w_down + (size_t)l * kDFF * kD, kD, (u16*)(ws + OFF_WDN) + (size_t)l * kD * kDFF, kDFF, (r / 64) * 64, (r % 64) * 64, false, (float*)lds);
    }
  }
  {
    const float4* src = (const float4*)p.x; uint2* xb = (uint2*)(ws + OFF_XB);
    const size_t n4 = (size_t)kM * kD / 4;
    for (size_t i = (size_t)blockIdx.x * 256 + tidx(); i < n4; i += (size_t)gridDim.x * 256) {
      const float4 v = src[i]; uint2 o; o.x = pack2(v.x, v.y); o.y = pack2(v.z, v.w); xb[i] = o;
    }
  }
  {
    float2* r32 = (float2*)(ws + OFF_R32); float2* r16 = (float2*)(ws + OFF_R16);
    for (int i = blockIdx.x * 256 + tidx(); i < kT * 48; i += gridDim.x * 256) {
      if (i < kT * 32) {
        const int t = i >> 5, f = i & 31; const float inv = powf(10000.0f, -(float)f / 32.0f); const float ang = (float)t * inv;
        double s, c; sincos((double)ang, &s, &c); r32[i] = make_float2((float)c, (float)s);
      } else {
        const int k = i - kT * 32; const int t = k >> 4, f = k & 15; const float inv = powf(10000.0f, -(float)f / 16.0f); const float ang = (float)t * inv;
        double s, c; sincos((double)ang, &s, &c); r16[k] = make_float2((float)c, (float)s);
      }
    }
  }
}

enum { EPI_INPROJ = 0, EPI_RESID = 1, EPI_RELU2 = 2 };

DI float logsigmoid(float z) { return fminf(z, 0.f) - log1pf(expf(-fabsf(z))); }

template <int EPI>
DI void gemm_tile(const Params& p, const u16* __restrict__ Wt, const u16* __restrict__ X, const int K, const int m0, const int n0, const int layer, char* lds) {
  const int tid = tidx(), lane = tid & 63, wid = __builtin_amdgcn_readfirstlane(tid >> 6), r32 = lane & 31, hi = lane >> 5;
  const int wm = wid & 1, wn = wid >> 1;
  f32x16 acc[2][4];
#pragma unroll
  for (int i = 0; i < 2; ++i)
#pragma unroll
    for (int j = 0; j < 4; ++j)
#pragma unroll
      for (int r = 0; r < 16; ++r) acc[i][j][r] = 0.f;
  char* Ws = lds; char* Xs = lds + 18432;
  const int srow = tid >> 3, sch = tid & 7;
  const u16* wsrc = Wt + (size_t)(n0 + srow) * K + sch * 8;
  const u16* xsrc = X + (size_t)(m0 + srow) * K + sch * 8;
  u32x4 w0, w1, w2, w3, x0, x1, x2, x3, x4, x5, x6, x7;
#define GLD(e, koff) *(const u32x4*)(wsrc + (size_t)(32 * (e)) * K + (koff))
#define GLDX(e, koff) *(const u32x4*)(xsrc + (size_t)(32 * (e)) * K + (koff))
  w0 = GLD(0, 0); w1 = GLD(1, 0); w2 = GLD(2, 0); w3 = GLD(3, 0);
  x0 = GLDX(0, 0); x1 = GLDX(1, 0); x2 = GLDX(2, 0); x3 = GLDX(3, 0); x4 = GLDX(4, 0); x5 = GLDX(5, 0); x6 = GLDX(6, 0); x7 = GLDX(7, 0);
  const int nk = K >> 6;
  for (int kt = 0; kt < nk; ++kt) {
    __syncthreads();
    *(u32x4*)(Ws + (srow + 0) * 144 + sch * 16) = w0; *(u32x4*)(Ws + (srow + 32) * 144 + sch * 16) = w1;
    *(u32x4*)(Ws + (srow + 64) * 144 + sch * 16) = w2; *(u32x4*)(Ws + (srow + 96) * 144 + sch * 16) = w3;
    *(u32x4*)(Xs + (srow + 0) * 144 + sch * 16) = x0; *(u32x4*)(Xs + (srow + 32) * 144 + sch * 16) = x1;
    *(u32x4*)(Xs + (srow + 64) * 144 + sch * 16) = x2; *(u32x4*)(Xs + (srow + 96) * 144 + sch * 16) = x3;
    *(u32x4*)(Xs + (srow + 128) * 144 + sch * 16) = x4; *(u32x4*)(Xs + (srow + 160) * 144 + sch * 16) = x5;
    *(u32x4*)(Xs + (srow + 192) * 144 + sch * 16) = x6; *(u32x4*)(Xs + (srow + 224) * 144 + sch * 16) = x7;
    __syncthreads();
    if (kt + 1 < nk) {
      const int ko = (kt + 1) * 64;
      w0 = GLD(0, ko); w1 = GLD(1, ko); w2 = GLD(2, ko); w3 = GLD(3, ko);
      x0 = GLDX(0, ko); x1 = GLDX(1, ko); x2 = GLDX(2, ko); x3 = GLDX(3, ko); x4 = GLDX(4, ko); x5 = GLDX(5, ko); x6 = GLDX(6, ko); x7 = GLDX(7, ko);
    }
    __builtin_amdgcn_sched_barrier(0);
#pragma unroll
    for (int kk = 0; kk < 4; ++kk) {
      bf16x8 wf[2], xf[4];
#pragma unroll
      for (int i = 0; i < 2; ++i) wf[i] = *(const bf16x8*)(Ws + (wn * 64 + i * 32 + r32) * 144 + kk * 32 + hi * 16);
#pragma unroll
      for (int j = 0; j < 4; ++j) xf[j] = *(const bf16x8*)(Xs + (wm * 128 + j * 32 + r32) * 144 + kk * 32 + hi * 16);
#pragma unroll
      for (int i = 0; i < 2; ++i)
#pragma unroll
        for (int j = 0; j < 4; ++j) acc[i][j] = MFMA32(wf[i], xf[j], acc[i][j]);
    }
  }
  const int nb = n0 + wn * 64, mb = m0 + wm * 128;
  char* ws = wsp(p);
  __syncthreads();
  char* stg = lds + wid * 9216;
  if (EPI == EPI_RESID) {
    float* out = outp(p);
    const bool first_res = (layer == 0 && K == kD);
    const u16* xbres = (const u16*)(ws + OFF_XB);
#pragma unroll
    for (int j = 0; j < 4; ++j) {
#pragma unroll
      for (int i = 0; i < 2; ++i)
#pragma unroll
        for (int g = 0; g < 4; ++g) {
          f32x4 v = {acc[i][j][4 * g + 0], acc[i][j][4 * g + 1], acc[i][j][4 * g + 2], acc[i][j][4 * g + 3]};
          *(f32x4*)(stg + r32 * 272 + (i * 32 + 8 * g + 4 * hi) * 4) = v;
        }
      __builtin_amdgcn_fence(__ATOMIC_RELEASE, "wavefront");
#pragma unroll
      for (int it = 0; it < 8; ++it) {
        const int row = it * 4 + (lane >> 4), ch = lane & 15;
        const f32x4 a = *(const f32x4*)(stg + row * 272 + ch * 16);
        const size_t eo = (size_t)(mb + j * 32 + row) * kD + nb + ch * 4;
        f32x4 v;
        if (first_res) v = *(const f32x4*)(p.x + eo);
        else { const uint2 xv = *(const uint2*)(xbres + eo); v = (f32x4){__uint_as_float(xv.x << 16), __uint_as_float(xv.x & 0xffff0000u), __uint_as_float(xv.y << 16), __uint_as_float(xv.y & 0xffff0000u)}; }
        v = v * kAlpha + a;
        *(f32x4*)(out + eo) = v;
      }
      __builtin_amdgcn_fence(__ATOMIC_RELEASE, "wavefront");
    }
  } else if (EPI == EPI_RELU2) {
    u16* H = (u16*)(ws + OFF_QKV);
#pragma unroll
    for (int jp = 0; jp < 2; ++jp) {
#pragma unroll
      for (int jj = 0; jj < 2; ++jj)
#pragma unroll
        for (int i = 0; i < 2; ++i)
#pragma unroll
          for (int g = 0; g < 4; ++g) {
            const int j = jp * 2 + jj;
            float a0 = fmaxf(acc[i][j][4 * g + 0], 0.f), a1 = fmaxf(acc[i][j][4 * g + 1], 0.f), a2 = fmaxf(acc[i][j][4 * g + 2], 0.f), a3 = fmaxf(acc[i][j][4 * g + 3], 0.f);
            uint2 o; o.x = pack2(a0 * a0, a1 * a1); o.y = pack2(a2 * a2, a3 * a3);
            *(uint2*)(stg + (jj * 32 + r32) * 144 + (i * 32 + 8 * g + 4 * hi) * 2) = o;
          }
      __builtin_amdgcn_fence(__ATOMIC_RELEASE, "wavefront");
#pragma unroll
      for (int it = 0; it < 8; ++it) {
        const int row = it * 8 + (lane >> 3), ch = lane & 7;
        const u32x4 v = *(const u32x4*)(stg + row * 144 + ch * 16);
        *(u32x4*)(H + (size_t)(mb + jp * 64 + row) * kDFF + nb + ch * 8) = v;
      }
      __builtin_amdgcn_fence(__ATOMIC_RELEASE, "wavefront");
    }
  } else {
    u16* QKV = (u16*)(ws + OFF_QKV); u16* IDXQ = (u16*)(ws + OFF_IDXQ); u16* IDXK = (u16*)(ws + OFF_IDXK);
    float* WI = (float*)(ws + OFF_WI); float* LOGF = (float*)(ws + OFF_LOGF);
    const float* rope32 = (const float*)(ws + OFF_R32); const float* rope16 = (const float*)(ws + OFF_R16);
    if (nb < kNQKV) {
      const int seg = nb >> 8; const int typ = seg % 3; const bool dorope = (seg >= 3) && (typ != 2);
      const float sc = (typ == 0) ? kQScale : 1.f;
#pragma unroll
      for (int jp = 0; jp < 2; ++jp) {
#pragma unroll
        for (int jj = 0; jj < 2; ++jj) {
          const int j = jp * 2 + jj;
          const int m = mb + j * 32 + r32; const int t = m & (kT - 1);
#pragma unroll
          for (int g = 0; g < 4; ++g) {
            float a0[4], a1[4];
#pragma unroll
            for (int e = 0; e < 4; ++e) { a0[e] = acc[0][j][4 * g + e]; a1[e] = acc[1][j][4 * g + e]; }
            if (dorope) {
              const float4* rp = (const float4*)(rope32 + ((size_t)t * 32 + 8 * g + 4 * hi) * 2);
              const float4 c01 = rp[0], c23 = rp[1];
              const float cs[4] = {c01.x, c01.z, c23.x, c23.z}; const float sn[4] = {c01.y, c01.w, c23.y, c23.w};
#pragma unroll
              for (int e = 0; e < 4; ++e) { const float x1 = a0[e], x2 = a1[e]; a0[e] = x1 * cs[e] - x2 * sn[e]; a1[e] = x2 * cs[e] + x1 * sn[e]; }
            }
            uint2 o0, o1;
            o0.x = pack2(a0[0] * sc, a0[1] * sc); o0.y = pack2(a0[2] * sc, a0[3] * sc);
            o1.x = pack2(a1[0] * sc, a1[1] * sc); o1.y = pack2(a1[2] * sc, a1[3] * sc);
            char* d = stg + (jj * 32 + r32) * 144 + (8 * g + 4 * hi) * 2;
            *(uint2*)d = o0; *(uint2*)(d + 64) = o1;
          }
        }
        __builtin_amdgcn_fence(__ATOMIC_RELEASE, "wavefront");
#pragma unroll
        for (int it = 0; it < 8; ++it) {
          const int row = it * 8 + (lane >> 3), ch = lane & 7;
          const u32x4 v = *(const u32x4*)(stg + row * 144 + ch * 16);
          *(u32x4*)(QKV + (size_t)(mb + jp * 64 + row) * kNQKV + nb + ch * 8) = v;
        }
        __builtin_amdgcn_fence(__ATOMIC_RELEASE, "wavefront");
      }
    } else if (nb <= 3328) {
#pragma unroll
      for (int j = 0; j < 4; ++j) {
        const int m = mb + j * 32 + r32; const int t = m & (kT - 1);
#pragma unroll
        for (int i = 0; i < 2; ++i) {
          if (nb == 3328 && i == 1) {
            float4 w; w.x = acc[1][j][0]; w.y = acc[1][j][1]; w.z = acc[1][j][2]; w.w = acc[1][j][3];
            *(float4*)(WI + (size_t)m * 8 + 4 * hi) = w;
            if (hi == 0) {
              const float* bf = p.b_f + layer * 4;
              float4 f;
              f.x = logsigmoid(acc[1][j][4] + bf[0]); f.y = logsigmoid(acc[1][j][5] + bf[1]);
              f.z = logsigmoid(acc[1][j][6] + bf[2]); f.w = logsigmoid(acc[1][j][7] + bf[3]);
              *(float4*)(LOGF + (size_t)m * 4) = f;
            }
          } else {
#pragma unroll
            for (int gg = 0; gg < 2; ++gg) {
              const float4* rp = (const float4*)(rope16 + ((size_t)t * 16 + 8 * gg + 4 * hi) * 2);
              const float4 c01 = rp[0], c23 = rp[1];
              const float cs[4] = {c01.x, c01.z, c23.x, c23.z}; const float sn[4] = {c01.y, c01.w, c23.y, c23.w};
              float o1[4], o2[4];
#pragma unroll
              for (int e = 0; e < 4; ++e) { const float x1 = acc[i][j][4 * gg + e], x2 = acc[i][j][4 * gg + 8 + e]; o1[e] = x1 * cs[e] - x2 * sn[e]; o2[e] = x2 * cs[e] + x1 * sn[e]; }
              uint2 p1, p2; p1.x = pack2(o1[0], o1[1]); p1.y = pack2(o1[2], o1[3]); p2.x = pack2(o2[0], o2[1]); p2.y = pack2(o2[2], o2[3]);
              u16* dst = (nb == 3328) ? (IDXK + (size_t)m * 32 + 8 * gg + 4 * hi) : (IDXQ + (size_t)m * 256 + (nb - kNQKV) + i * 32 + 8 * gg + 4 * hi);
              *(uint2*)dst = p1; *(uint2*)(dst + 16) = p2;
            }
          }
        }
      }
    }
  }
}
#undef GLD
#undef GLDX
struct XQ { unsigned* c; int step; unsigned xcc; };
DI int xq_pull(XQ& q, const int per_queue, int* slot, const int max_step) {
  for (;;) {
    if (q.step >= max_step) return -1;
    const int xq = (int)((q.xcc + (unsigned)q.step) & 7u);
    __syncthreads();
    if (threadIdx.x == 0) *slot = (int)atomicAdd(q.c + xq, 1u);
    __syncthreads();
    const int t = __builtin_amdgcn_readfirstlane(*slot);
    if (t < per_queue) return xq * per_queue + t;
    ++q.step;
  }
}

template <int EPI>
DI void gemm_phase(const Params& p, const u16* Wt, const u16* X, const int N, const int K, const int layer, char* lds, unsigned* qcnt, int* slot, const unsigned xcc) {
  const int ntn = N >> 7; const int per_queue = 16 * ntn;
  XQ q; q.c = qcnt; q.step = 0; q.xcc = xcc;
  for (int v = xq_pull(q, per_queue, slot, 8); v >= 0; v = xq_pull(q, per_queue, slot, 8)) {
    const int xq = v / per_queue, tk = v % per_queue;
    const int band = xq * 4 + tk / (4 * ntn); const int r = tk % (4 * ntn);
    const int nt = (r >> 6) * 16 + ((r & 63) >> 2), mt = band * 4 + (r & 3);
    gemm_tile<EPI>(p, Wt, X, K, mt * 256, nt * 128, layer, lds);
  }
}

DI float wave_sum(float v) {
#pragma unroll
  for (int off = 32; off > 0; off >>= 1) v += __shfl_xor(v, off);
  return v;
}
DI void ln_phase(const Params& p, const float* __restrict__ g, const float* __restrict__ bta, const bool last) {
  const int lane = tidx() & 63, wid = __builtin_amdgcn_readfirstlane(tidx() >> 6);
  float* x = outp(p); u16* xb = (u16*)(wsp(p) + OFF_XB);
  float4 gg[4], bb[4];
#pragma unroll
  for (int i = 0; i < 4; ++i) { gg[i] = *(const float4*)(g + (lane + 64 * i) * 4); bb[i] = *(const float4*)(bta + (lane + 64 * i) * 4); }
  for (int row = blockIdx.x * 4 + wid; row < kM; row += gridDim.x * 4) {
    float4* xr = (float4*)(x + (size_t)row * kD);
    float4 v[4]; float s = 0.f;
#pragma unroll
    for (int i = 0; i < 4; ++i) { v[i] = xr[lane + 64 * i]; s += v[i].x + v[i].y + v[i].z + v[i].w; }
    const float mean = wave_sum(s) * (1.0f / kD);
    float q = 0.f;
#pragma unroll
    for (int i = 0; i < 4; ++i) { v[i].x -= mean; v[i].y -= mean; v[i].z -= mean; v[i].w -= mean; q += v[i].x * v[i].x + v[i].y * v[i].y + v[i].z * v[i].z + v[i].w * v[i].w; }
    const float rstd = 1.0f / sqrtf(wave_sum(q) * (1.0f / kD) + kLnEps);
#pragma unroll
    for (int i = 0; i < 4; ++i) {
      float4 y;
      y.x = v[i].x * rstd * gg[i].x + bb[i].x; y.y = v[i].y * rstd * gg[i].y + bb[i].y;
      y.z = v[i].z * rstd * gg[i].z + bb[i].z; y.w = v[i].w * rstd * gg[i].w + bb[i].w;
      if (last) xr[lane + 64 * i] = y;
      uint2 o; o.x = pack2(y.x, y.y); o.y = pack2(y.z, y.w);
      if (!last) *(uint2*)(xb + (size_t)row * kD + (lane + 64 * i) * 4) = o;
    }
  }
}

DI void cumsum_item(const Params& p, const int bh, char* lds) {
  const int tid = tidx(); const int b = bh >> 2, h = bh & 3;
  const float* LOGF = (const float*)(wsp(p) + OFF_LOGF); float* CB = (float*)(wsp(p) + OFF_CB);
  float* part = (float*)lds;
  const float* src = LOGF + ((size_t)b * kT + tid * 32) * 4 + h;
  float s = 0.f;
  for (int i = 0; i < 32; ++i) s += src[i * 4];
  part[tid] = s;
  __syncthreads();
  float pre = 0.f;
  for (int i = 0; i < tid; ++i) pre += part[i];
  float run = pre;
  float* dst = CB + (size_t)bh * kT + tid * 32;
  for (int i = 0; i < 32; ++i) { run += src[i * 4]; dst[i] = run * kLog2e; }
  __syncthreads();
  {
    const u16* QKV = (const u16*)(wsp(p) + OFF_QKV);
    float mx = 0.f;
    for (int i = 0; i < 32; ++i) {
      const u16* kp = QKV + ((size_t)b * kT + tid * 32 + i) * kNQKV + 256 + h * 64;
      float ss = 0.f;
#pragma unroll
      for (int c = 0; c < 8; ++c) {
        const u32x4 v = *(const u32x4*)(kp + c * 8);
#pragma unroll
        for (int e = 0; e < 4; ++e) { const float a = __uint_as_float(v[e] << 16), bq = __uint_as_float(v[e] & 0xffff0000u); ss += a * a + bq * bq; }
      }
      mx = fmaxf(mx, ss);
    }
    part[tid] = mx;
    __syncthreads();
    if (tid == 0) { float m = 0.f; for (int i = 0; i < 256; ++i) m = fmaxf(m, part[i]); ((float*)(wsp(p) + OFF_KMAX))[bh] = sqrtf(m) * 1.002f; }
    __syncthreads();
  }
}

DI void kmean_item(const Params& p, const int idx) {
  const int tid = tidx(); const int b = idx >> 5, blk = idx & 31;
  const u16* QKV = (const u16*)(wsp(p) + OFF_QKV); u16* KMEAN = (u16*)(wsp(p) + OFF_KMEAN);
  const u16* src = QKV + ((size_t)b * kT + blk * 256) * kNQKV + 2560 + tid;
  float s = 0.f;
  for (int i = 0; i < 256; ++i) s += __uint_as_float((unsigned)src[(size_t)i * kNQKV] << 16);
  KMEAN[(((size_t)b * 32 + blk) * 4 + (tid >> 6)) * 64 + (tid & 63)] = f2bf(s * (1.0f / 256.0f));
}

#if SELFCHECK
DI void sc_flag2(const Params& p, unsigned idx) { atomicOr((unsigned*)(wsp(p) + OFF_CNT) + 200, 1u << idx); }
#endif
DI void select_item(const Params& p, const int b, const int t0, char* lds) {
  const int tid = tidx(), lane = tid & 63, wid = __builtin_amdgcn_readfirstlane(tid >> 6), r32 = lane & 31, hi = lane >> 5;
  u16* S16 = (u16*)lds; unsigned* hist = (unsigned*)(lds + 65536); u16* tl_idx = (u16*)(lds + 65536 + 4096); float* tl_sc = (float*)(lds + 65536 + 4096 + 2048);
  char* ws = wsp(p);
  const u16* IDXQ = (const u16*)(ws + OFF_IDXQ); const u16* IDXK = (const u16*)(ws + OFF_IDXK); const float* WI = (const float*)(ws + OFF_WI);
  u64* MASK = (u64*)(ws + OFF_MASK);
  const bool all = (t0 + 3 < 256);
  const int npad = (t0 | 127) + 1;
  const size_t rb = (size_t)b * kT;
  if (!all) {
    {
      const int hc = (r32 >> 2) & 1, ii = (r32 & 3) + 4 * (r32 >> 3);
      const int aq = 2 * hc + (ii >> 3), ah = ii & 7;
      const u16* ap = IDXQ + (rb + t0 + aq) * 256 + ah * 32 + hi * 8;
      const bf16x8 af0 = *(const bf16x8*)ap, af1 = *(const bf16x8*)(ap + 16);
      const float* wp = WI + (rb + t0 + 2 * hi) * 8;
      const float4 wa0 = *(const float4*)wp, wa1 = *(const float4*)(wp + 4), wb0 = *(const float4*)(wp + 8), wb1 = *(const float4*)(wp + 12);
      const int nchunks = (t0 + 4 + 31) >> 5;
      const u16* kp = IDXK + (rb + r32) * 32 + hi * 8;
      u16* s_a = S16 + (2 * hi) * 8192 + r32; u16* s_b = s_a + 8192;
      for (int c0 = wid; c0 < nchunks; c0 += 32) {
        bf16x8 k0[8], k1[8];
#pragma unroll
        for (int u = 0; u < 8; ++u) { const int c = min(c0 + 4 * u, nchunks - 1); const u16* q_ = kp + (size_t)c * 32 * 32; k0[u] = *(const bf16x8*)q_; k1[u] = *(const bf16x8*)(q_ + 16); }
        __builtin_amdgcn_sched_barrier(0);
#pragma unroll
        for (int u = 0; u < 8; ++u) {
          const int c = c0 + 4 * u;
          if (c < nchunks) {
            f32x16 acc;
#pragma unroll
            for (int r = 0; r < 16; ++r) acc[r] = 0.f;
            acc = MFMA32(af0, k0[u], acc); acc = MFMA32(af1, k1[u], acc);
            float sa = wa0.x * fmaxf(acc[0], 0.f) + wa0.y * fmaxf(acc[1], 0.f) + wa0.z * fmaxf(acc[2], 0.f) + wa0.w * fmaxf(acc[3], 0.f)
                     + wa1.x * fmaxf(acc[4], 0.f) + wa1.y * fmaxf(acc[5], 0.f) + wa1.z * fmaxf(acc[6], 0.f) + wa1.w * fmaxf(acc[7], 0.f);
            float sb = wb0.x * fmaxf(acc[8], 0.f) + wb0.y * fmaxf(acc[9], 0.f) + wb0.z * fmaxf(acc[10], 0.f) + wb0.w * fmaxf(acc[11], 0.f)
                     + wb1.x * fmaxf(acc[12], 0.f) + wb1.y * fmaxf(acc[13], 0.f) + wb1.z * fmaxf(acc[14], 0.f) + wb1.w * fmaxf(acc[15], 0.f);
            s_a[c * 32] = (u16)(okey(sa + 0.0f) >> 16); s_b[c * 32] = (u16)(okey(sb + 0.0f) >> 16);
          }
        }
      }
    }
    __syncthreads();
  }
  {
    const int q = wid; const int tq = t0 + q; const int nq = tq + 1;
    u16* Sq = S16 + q * 8192; unsigned* hq = hist + q * 256; u16* li = tl_idx + q * 256; float* ls = tl_sc + q * 256; float* qf32 = (float*)hq;
    unsigned thr = 0;
    if (!all) {
      unsigned prefix = 0; int krem = 256; unsigned cnt_eq = 0;
#pragma unroll
      for (int pass = 0; pass < 2; ++pass) {
        { const unsigned z0 = (unsigned)tid >> 30; u32x4 zz = {z0, z0, z0, z0}; *(u32x4*)(hq + lane * 4) = zz; }
        asm volatile("s_waitcnt lgkmcnt(0)" ::: "memory");
        for (int i = lane * 8; i < nq; i += 512) {
          const u32x4 v = *(const u32x4*)(Sq + i);
#pragma unroll
          for (int e = 0; e < 8; ++e) {
            if (i + e < nq) {
              const unsigned key = (e & 1) ? (v[e >> 1] >> 16) : (v[e >> 1] & 0xffffu);
              const bool match = (pass == 0) ? true : ((key >> 8) == prefix);
              if (match) atomicAdd(&hq[(pass == 0) ? (key >> 8) : (key & 255u)], 1u);
            }
          }
        }
        asm volatile("s_waitcnt lgkmcnt(0)" ::: "memory");
        const u32x4 c = *(const u32x4*)(hq + 4 * lane);
        const unsigned s_ = c[0] + c[1] + c[2] + c[3]; unsigned incl = s_;
#pragma unroll
        for (int off = 1; off < 64; off <<= 1) { const unsigned v = __shfl_down(incl, off); if (lane + off < 64) incl += v; }
        const unsigned excl = incl - s_;
        const bool has = (excl < (unsigned)krem) && (incl >= (unsigned)krem);
        unsigned bsel = 0, above = 0, cbin = 0;
        {
          unsigned cum = excl;
          if (cum + c[3] >= (unsigned)krem) { bsel = 4 * lane + 3; above = cum; cbin = c[3]; }
          else { cum += c[3];
            if (cum + c[2] >= (unsigned)krem) { bsel = 4 * lane + 2; above = cum; cbin = c[2]; }
            else { cum += c[2];
              if (cum + c[1] >= (unsigned)krem) { bsel = 4 * lane + 1; above = cum; cbin = c[1]; }
              else { cum += c[1]; bsel = 4 * lane; above = cum; cbin = c[0]; } } }
        }
        const u64 bm = __ballot(has); const int srcl = bm ? (__ffsll((long long)bm) - 1) : 0;
        bsel = __shfl(bsel, srcl); above = __shfl(above, srcl); cbin = __shfl(cbin, srcl);
        prefix = (prefix << 8) | bsel; krem -= (int)above; cnt_eq = cbin;
      }
      thr = prefix;
#if SELFCHECK
      {
        int cg_ = 0, ce_ = 0;
        for (int base = 0; base < nq; base += 64) { const int j = base + lane; const unsigned kk_ = (j < nq) ? (unsigned)Sq[j] : 0u; cg_ += __popcll(__ballot(j < nq && kk_ > thr)); ce_ += __popcll(__ballot(j < nq && kk_ == thr)); }
        if (cg_ != 256 - krem) sc_flag2(p, 19);
        if ((unsigned)ce_ != cnt_eq) sc_flag2(p, 18);
      }
#endif
      if (cnt_eq != (unsigned)krem) {
        int nmem = 0;
        for (int i0 = 0; i0 < nq; i0 += 512) {
          const int i = i0 + lane * 8;
          unsigned mm = 0;
          if (i < nq) {
            const u32x4 v = *(const u32x4*)(Sq + i);
#pragma unroll
            for (int e = 0; e < 8; ++e) {
              const unsigned key = (e & 1) ? (v[e >> 1] >> 16) : (v[e >> 1] & 0xffffu);
              if (i + e < nq && key == thr) mm |= 1u << e;
            }
          }
          u64 anyb = __ballot(mm != 0u);
          while (anyb) {
            const int L = __ffsll((long long)anyb) - 1; anyb &= anyb - 1ull;
            const unsigned m8 = __shfl(mm, L);
#pragma unroll
            for (int e = 0; e < 8; ++e) {
              if ((m8 >> e) & 1u) { if (nmem < 256 && lane == 0) li[nmem] = (u16)(i0 + L * 8 + e); ++nmem; }
            }
          }
        }
        asm volatile("s_waitcnt lgkmcnt(0)" ::: "memory");
        if (nmem <= 256) {
          const float* wr = WI + (rb + tq) * 8;
          for (int m0_ = 0; m0_ < nmem; m0_ += 64) {
            const int m = m0_ + lane;
            if (m < nmem) {
              const int j = li[m];
              const u16* kr = IDXK + (rb + j) * 32;
              float tot = 0.f;
              const u16* qr = IDXQ + (rb + tq) * 256;
#pragma unroll 1
              for (int h = 0; h < 8; ++h) {
                float d_ = 0.f;
#pragma unroll
                for (int c = 0; c < 4; ++c) {
                  const u32x4 qv = *(const u32x4*)(qr + h * 32 + c * 8); const u32x4 kv_ = *(const u32x4*)(kr + c * 8);
#pragma unroll
                  for (int e = 0; e < 4; ++e)
                    d_ += __uint_as_float(qv[e] << 16) * __uint_as_float(kv_[e] << 16) + __uint_as_float(qv[e] & 0xffff0000u) * __uint_as_float(kv_[e] & 0xffff0000u);
                }
                tot += wr[h] * fmaxf(d_, 0.f);
              }
              ls[m] = tot + 0.0f;
            }
          }
          asm volatile("s_waitcnt lgkmcnt(0)" ::: "memory");
          for (int m0_ = 0; m0_ < nmem; m0_ += 64) {
            const int m = m0_ + lane;
            if (m < nmem) {
              const float sm = ls[m]; const int jm = li[m]; int rank = 0;
              for (int o = 0; o < nmem; ++o) { const float so = ls[o]; const int jo = li[o]; rank += (so > sm || (so == sm && jo < jm)) ? 1 : 0; }
              if (rank < krem) Sq[jm] = (u16)0xFFFFu;
            }
          }
        } else {
          int taken = 0;
          for (int base = 0; base < nq; base += 64) {
            const int j = base + lane;
            const bool mem = (j < nq) && ((unsigned)Sq[j < nq ? j : 0] == thr);
            const u64 mb = __ballot(mem);
            if (mem) { const int pos = taken + __popcll(mb & ((1ull << lane) - 1ull)); if (pos < krem) Sq[j] = (u16)0xFFFFu; }
            taken += __popcll(mb);
          }
        }
        asm volatile("s_waitcnt lgkmcnt(0)" ::: "memory");
      } else {
        thr = thr - 1u;
      }
    }
    {
      const int nIt = (npad + 255) >> 8;
      int tot_bits = 0;
      u64* mbase = MASK + ((size_t)(b * 256 + (tq >> 5)) * 128) * 32 + (tq & 31);
      for (int it = 0; it < nIt; ++it) {
        const int kbase = it * 256 + lane * 4;
        unsigned k01 = 0, k23 = 0;
        if (!all) { const uint2 v = *(const uint2*)(Sq + kbase); k01 = v.x; k23 = v.y; }
        const unsigned kv[4] = {k01 & 0xffffu, k01 >> 16, k23 & 0xffffu, k23 >> 16};
        u64 gsel[4];
#pragma unroll
        for (int e = 0; e < 4; ++e) { const bool valid = (kbase + e) <= tq; gsel[e] = __ballot(valid && (all || kv[e] > thr)); }
        u64 wt[4];
#pragma unroll
        for (int tau = 0; tau < 4; ++tau) {
          u64 acc_ = 0;
#pragma unroll
          for (int e = 0; e < 4; ++e) acc_ |= ((gsel[e] >> (16 * tau)) & 0xFFFFull) << (16 * e);
          wt[tau] = acc_;
        }
        const u64 wv = (lane == 0) ? wt[0] : (lane == 1) ? wt[1] : (lane == 2) ? wt[2] : wt[3];
        const int tile = it * 4 + lane;
        if (lane < 4 && tile * 64 < npad) mbase[(size_t)tile * 32] = wv;
#if SELFCHECK
        tot_bits += __popcll(gsel[0]) + __popcll(gsel[1]) + __popcll(gsel[2]) + __popcll(gsel[3]);
#endif
      }
#if SELFCHECK
      if (!all && tot_bits != 256) sc_flag2(p, 16);
      if (!all && tot_bits > 256 + 64) sc_flag2(p, 17);
#endif
    }
  }
  __syncthreads();
}

enum { M_FOX = 0, M_DSA = 1, M_DIL = 2, M_MOBA = 3 };

template <int MODE>
DI void attn_item(const Params& p, const int b, const int h, const int sub, char* lds) {
  const int tid = tidx(), lane = tid & 63, wid = __builtin_amdgcn_readfirstlane(tid >> 6), r32 = lane & 31, hi = lane >> 5;
  char* ws = wsp(p);
  const u16* QKV = (const u16*)(ws + OFF_QKV); u16* O = (u16*)(ws + OFF_O);
  constexpr int grp = MODE;
  const int qcol = grp * 768 + h * 64, kcol = qcol + 256, vcol = qcol + 512;
  const size_t rowbase = (size_t)b * kT;
  int tq, tw_lo, tw_hi, qt = 0, it = 0, res16 = 0;
  if (MODE == M_DIL) { res16 = sub >> 4; it = sub & 15; tq = (it * 32 + r32) * 16 + res16 + 4 * wid; tw_lo = (it * 32) * 16 + res16 + 4 * wid; tw_hi = tw_lo + 31 * 16; }
  else { qt = sub; tq = qt * 128 + wid * 32 + r32; tw_lo = qt * 128 + wid * 32; tw_hi = tw_lo + 31; }
  bf16x8 qf[4];
  {
    const u16* qp = QKV + (rowbase + tq) * kNQKV + qcol + hi * 8;
#pragma unroll
    for (int d0 = 0; d0 < 4; ++d0) qf[d0] = *(const bf16x8*)(qp + d0 * 16);
  }
  const int ntiles = (MODE == M_DIL) ? 26 : (2 * qt + 2);
  unsigned selmask = 0;
  if (MODE == M_MOBA) {
    const int own = qt >> 1;
    const u16* KMEAN = (const u16*)(ws + OFF_KMEAN);
    f32x16 g;
#pragma unroll
    for (int r = 0; r < 16; ++r) g[r] = 0.f;
#pragma unroll
    for (int d0 = 0; d0 < 4; ++d0) {
      const bf16x8 kmf = *(const bf16x8*)(KMEAN + (((size_t)b * 32 + r32) * 4 + h) * 64 + d0 * 16 + hi * 8);
      g = MFMA32(kmf, qf[d0], g);
    }
#pragma unroll
    for (int round = 0; round < 3; ++round) {
      float best = -INFINITY; int bi = 99;
#pragma unroll
      for (int r = 0; r < 16; ++r) {
        const int n = crow(r, hi);
        if (n < own && !((selmask >> n) & 1u) && g[r] > best) { best = g[r]; bi = n; }
      }
      const float ob = __shfl_xor(best, 32); const int obi = __shfl_xor(bi, 32);
      if (ob > best || (ob == best && obi < bi)) { best = ob; bi = obi; }
      if (bi < 32) selmask |= (1u << bi);
    }
    selmask |= (1u << own);
  }
  const u64* mrow = (const u64*)(ws + OFF_MASK) + ((size_t)(b * 256 + (tq >> 5)) * 128) * 32 + (tq & 31);
  const float* cbp = (const float*)(ws + OFF_CB) + (size_t)(b * 4 + h) * kT;

  float m_run = -INFINITY, l_run = 0.f;
  f32x16 o0, o1;
#pragma unroll
  for (int r = 0; r < 16; ++r) { o0[r] = 0.f; o1[r] = 0.f; }
  char* Ks = lds; char* Vs = lds + 9216; float* CBs = (float*)(lds + 18432); float* AL = (float*)(lds + 18688 + wid * 128);
  const int srow = tid >> 3, sch = tid & 7;
  auto tile_desc = [&](const int j, int& lo, int& r) {
    if (MODE == M_DIL) {
      if (j < 12) { r = 16; lo = (it * 32 - 128 + 64 * (j % 3)) * 16 + res16 + 4 * (j / 3); }
      else if (j < 16) { r = 4; lo = (128 * it - 128 + 64 * (j - 12)) * 4 + res16; }
      else { r = 1; lo = 512 * it + res16 - 128 + 64 * (j - 16); }
    } else { r = 1; lo = 64 * j; }
  };
  u32x4 kr0, kr1, vr0, vr1; float cbreg = 0.f;
#define PREFETCH(jj) do { int lo_, r_; tile_desc((jj), lo_, r_); \
    { const int tpos = lo_ + srow * r_; \
      if (MODE != M_DIL || (tpos >= 0 && tpos < kT)) { const u16* base = QKV + (rowbase + tpos) * kNQKV + sch * 8; kr0 = *(const u32x4*)(base + kcol); vr0 = *(const u32x4*)(base + vcol); } \
      else { kr0 = (u32x4){0u, 0u, 0u, 0u}; vr0 = (u32x4){0u, 0u, 0u, 0u}; } } \
    { const int tpos = lo_ + (srow + 32) * r_; \
      if (MODE != M_DIL || (tpos >= 0 && tpos < kT)) { const u16* base = QKV + (rowbase + tpos) * kNQKV + sch * 8; kr1 = *(const u32x4*)(base + kcol); vr1 = *(const u32x4*)(base + vcol); } \
      else { kr1 = (u32x4){0u, 0u, 0u, 0u}; vr1 = (u32x4){0u, 0u, 0u, 0u}; } } \
    if (MODE == M_FOX) { if (tid < 64) cbreg = cbp[lo_ + tid]; } } while (0)
  float ubq = 0.f; bool wdone = false;
  if (MODE == M_FOX) {
    float ss = 0.f;
#pragma unroll
    for (int d0 = 0; d0 < 4; ++d0)
#pragma unroll
      for (int e = 0; e < 8; ++e) { const float a = __uint_as_float((unsigned)(unsigned short)qf[d0][e] << 16); ss += a * a; }
    ss += __shfl_xor(ss, 32);
    ubq = sqrtf(ss) * 1.002f * ((const float*)(ws + OFF_KMAX))[b * 4 + h];
  }
#define TILE_OF(j_) ((MODE == M_FOX) ? (ntiles - 1 - (j_)) : (j_))
  PREFETCH(TILE_OF(0));
  for (int j = 0; j < ntiles; ++j) {
    if (MODE == M_FOX) { if (__syncthreads_and(wdone ? 1 : 0)) break; }
    else __syncthreads();
    *(u32x4*)(Ks + srow * 144 + sch * 16) = kr0; *(u32x4*)(Ks + (srow + 32) * 144 + sch * 16) = kr1;
    *(u32x4*)(Vs + srow * 144 + sch * 16) = vr0; *(u32x4*)(Vs + (srow + 32) * 144 + sch * 16) = vr1;
    if (MODE == M_FOX) { if (tid < 64) CBs[tid] = cbreg; }
    __syncthreads();
    int lo, rs; tile_desc(TILE_OF(j), lo, rs);
    if (j + 1 < ntiles) PREFETCH(TILE_OF(j + 1));
    __builtin_amdgcn_sched_barrier(0);
    bool part;
    if (MODE == M_DIL) part = (lo <= tw_hi) && (lo + 63 * rs >= tw_lo - 128 * rs) && (TILE_OF(j) >= 12 || TILE_OF(j) / 3 == wid);
    else part = (lo <= tw_hi);
    if (MODE == M_FOX) {
      if (part && !wdone) { const float bound = ubq - CBs[63]; if (__all((bound - m_run) < -140.0f)) wdone = true; }
      part = part && !wdone;
    }
    if (part) {
      f32x16 s0, s1;
#pragma unroll
      for (int r = 0; r < 16; ++r) { s0[r] = 0.f; s1[r] = 0.f; }
#pragma unroll
      for (int d0 = 0; d0 < 4; ++d0) {
        const bf16x8 k0 = *(const bf16x8*)(Ks + r32 * 144 + d0 * 32 + hi * 16);
        const bf16x8 k1 = *(const bf16x8*)(Ks + (32 + r32) * 144 + d0 * 32 + hi * 16);
        s0 = MFMA32(k0, qf[d0], s0); s1 = MFMA32(k1, qf[d0], s1);
      }
      bool row_ok = true;
      if (MODE == M_FOX) {
#pragma unroll
        for (int g = 0; g < 4; ++g) {
          const float4 c0 = *(const float4*)(CBs + 8 * g + 4 * hi); const float4 c1 = *(const float4*)(CBs + 32 + 8 * g + 4 * hi);
          s0[4 * g + 0] -= c0.x; s0[4 * g + 1] -= c0.y; s0[4 * g + 2] -= c0.z; s0[4 * g + 3] -= c0.w;
          s1[4 * g + 0] -= c1.x; s1[4 * g + 1] -= c1.y; s1[4 * g + 2] -= c1.z; s1[4 * g + 3] -= c1.w;
        }
      }
      if (MODE == M_FOX || MODE == M_MOBA) {
        if (MODE == M_MOBA) row_ok = (selmask >> (lo >> 8)) & 1u;
        if (lo + 63 > tw_lo) {
#pragma unroll
          for (int r = 0; r < 16; ++r) {
            const int kp = lo + crow(r, hi);
            if (kp > tq) s0[r] = -INFINITY;
            if (kp + 32 > tq) s1[r] = -INFINITY;
          }
        }
      }
      if (MODE == M_DSA) {
        const u64 w = mrow[(size_t)j * 32];
#if SELFCHECK == 2
        const unsigned wl = ((unsigned)w & ~1u) >> hi, wh = (unsigned)(w >> 32) >> hi;
#else
        const unsigned wl = (unsigned)w >> hi, wh = (unsigned)(w >> 32) >> hi;
#endif
#pragma unroll
        for (int r = 0; r < 16; ++r) {
          const int e = r & 3, g = r >> 2;
          const unsigned word = (e < 2) ? wl : wh;
          const int bit = 16 * (e & 1) + 2 * g;
          const unsigned k0_ = (unsigned)__builtin_amdgcn_sbfe((int)word, bit, 1), k1_ = (unsigned)__builtin_amdgcn_sbfe((int)word, bit + 8, 1);
          s0[r] = __uint_as_float((__float_as_uint(s0[r]) & k0_) | (0xFF800000u & ~k0_));
          s1[r] = __uint_as_float((__float_as_uint(s1[r]) & k1_) | (0xFF800000u & ~k1_));
        }
      }
      if (MODE == M_DIL) {
        const unsigned lim = (unsigned)min(128 * rs, tq);
        const int dq = tq - lo - rs * 4 * hi;
#pragma unroll
        for (int r = 0; r < 16; ++r) {
          const int c_r = (r & 3) + 8 * (r >> 2);
          const int d0 = dq - rs * c_r, d1 = d0 - 32 * rs;
          if ((unsigned)d0 > lim) s0[r] = -INFINITY;
          if ((unsigned)d1 > lim) s1[r] = -INFINITY;
        }
      }
#define MX3(a_, b_, c_) __builtin_fmaxf(__builtin_fmaxf((a_), (b_)), (c_))
      float mxa = MX3(s0[0], s0[1], s1[0]), mxb = MX3(s0[2], s0[3], s1[1]); mxa = MX3(mxa, s1[2], s1[3]);
#pragma unroll
      for (int r = 4; r < 16; r += 4) { mxa = MX3(mxa, s0[r], s0[r + 1]); mxb = MX3(mxb, s0[r + 2], s0[r + 3]); mxa = MX3(mxa, s1[r], s1[r + 1]); mxb = MX3(mxb, s1[r + 2], s1[r + 3]); }
#undef MX3
      float mx = fmaxf(mxa, mxb);
      if (MODE == M_MOBA) mx = row_ok ? mx : -INFINITY;
      mx = fmaxf(mx, __shfl_xor(mx, 32));
      const float m_new = fmaxf(m_run, mx);
      const float m_safe = (m_new == -INFINITY) ? 0.f : m_new;
      const float alpha = ex2(m_run - m_safe);
      const float m_exp = (MODE == M_MOBA && !row_ok) ? INFINITY : m_safe;
      float sum = 0.f;
#pragma unroll
      for (int r = 0; r < 16; ++r) { s0[r] = ex2(s0[r] - m_exp); s1[r] = ex2(s1[r] - m_exp); sum += s0[r] + s1[r]; }
      l_run = l_run * alpha + sum; m_run = m_new;
      if (__any(alpha != 1.0f)) {
        if (hi == 0) AL[r32] = alpha;
        __builtin_amdgcn_fence(__ATOMIC_RELEASE, "wavefront");
#pragma unroll
        for (int g = 0; g < 4; ++g) {
          const float4 a4 = *(const float4*)(AL + 8 * g + 4 * hi);
          o0[4 * g + 0] *= a4.x; o0[4 * g + 1] *= a4.y; o0[4 * g + 2] *= a4.z; o0[4 * g + 3] *= a4.w;
          o1[4 * g + 0] *= a4.x; o1[4 * g + 1] *= a4.y; o1[4 * g + 2] *= a4.z; o1[4 * g + 3] *= a4.w;
        }
      }
      bf16x8 pa[4];
      {
        uint4 u;
        u.x = pack2(s0[0], s0[1]); u.y = pack2(s0[2], s0[3]); u.z = pack2(s0[4], s0[5]); u.w = pack2(s0[6], s0[7]); pa[0] = __builtin_bit_cast(bf16x8, u);
        u.x = pack2(s0[8], s0[9]); u.y = pack2(s0[10], s0[11]); u.z = pack2(s0[12], s0[13]); u.w = pack2(s0[14], s0[15]); pa[1] = __builtin_bit_cast(bf16x8, u);
        u.x = pack2(s1[0], s1[1]); u.y = pack2(s1[2], s1[3]); u.z = pack2(s1[4], s1[5]); u.w = pack2(s1[6], s1[7]); pa[2] = __builtin_bit_cast(bf16x8, u);
        u.x = pack2(s1[8], s1[9]); u.y = pack2(s1[10], s1[11]); u.z = pack2(s1[12], s1[13]); u.w = pack2(s1[14], s1[15]); pa[3] = __builtin_bit_cast(bf16x8, u);
      }
      {
        const int i16 = lane & 15, qq = i16 >> 2, pp = i16 & 3, blk = (lane >> 4) & 1;
        const lds_cptr vbase = (lds_cptr)Vs + (4 * hi + qq) * 144 + blk * 32 + pp * 8;
#pragma unroll
        for (int ks = 0; ks < 4; ++ks) {
#pragma unroll
          for (int dh = 0; dh < 2; ++dh) {
            const s16x4 lo4 = vtr(vbase + (ks * 16) * 144 + dh * 64);
            const s16x4 hi4 = vtr(vbase + (ks * 16 + 8) * 144 + dh * 64);
            const bf16x8 vf = __builtin_shufflevector(lo4, hi4, 0, 1, 2, 3, 4, 5, 6, 7);
            if (dh == 0) o0 = MFMA32(pa[ks], vf, o0); else o1 = MFMA32(pa[ks], vf, o1);
          }
        }
      }
    }
  }
  {
    const float l_tot = l_run + __shfl_xor(l_run, 32);
    if (hi == 0) AL[r32] = 1.0f / l_tot;
    __builtin_amdgcn_fence(__ATOMIC_RELEASE, "wavefront");
#pragma unroll
    for (int g = 0; g < 4; ++g) {
      const float4 a4 = *(const float4*)(AL + 8 * g + 4 * hi);
      const float av[4] = {a4.x, a4.y, a4.z, a4.w};
#pragma unroll
      for (int e = 0; e < 4; ++e) {
        const int qr = wid * 32 + 8 * g + 4 * hi + e;
        const int tqr = (MODE == M_DIL) ? ((it * 32 + (qr - wid * 32)) * 16 + res16 + 4 * wid) : (qt * 128 + qr);
        u16* dst = O + (rowbase + tqr) * kD + grp * 256 + h * 64 + r32;
        dst[0] = f2bf(o0[4 * g + e] * av[e]);
        dst[32] = f2bf(o1[4 * g + e] * av[e]);
      }
    }
  }
  __syncthreads();
}

#undef PREFETCH
#undef TILE_OF

#if SELFCHECK
DI float bf2f(u16 v) { return __uint_as_float((unsigned)v << 16); }
DI void sc_flag(const Params& p, unsigned idx) { atomicOr((unsigned*)(wsp(p) + OFF_CNT) + 200, 1u << idx); }
DI float blk_max(float v, float* red) {
  const int tid = tidx();
  red[tid] = v; __syncthreads();
  float m = -INFINITY; for (int i = 0; i < 256; ++i) m = fmaxf(m, red[i]);
  __syncthreads(); return m;
}
DI void check_attn(const Params& p, const int mode, const int b, const int t, const int h, char* lds) {
  const int tid = tidx();
  float* sc = (float*)lds; float* red = (float*)(lds + 32768); float* acc4 = (float*)(lds + 32768 + 1024); float* l4 = (float*)(lds + 32768 + 1024 + 1024);
  char* ws = wsp(p);
  const u16* QKV = (const u16*)(ws + OFF_QKV); const u16* O = (const u16*)(ws + OFF_O);
  const int qcol = mode * 768 + h * 64, kcol = qcol + 256, vcol = qcol + 512;
  const size_t rb = (size_t)b * kT;
  unsigned allowed = 0xffffffffu;
  if (mode == M_MOBA) {
    const int own = t >> 8; const u16* KMEAN = (const u16*)(ws + OFF_KMEAN);
    if (tid < 32) { float g = -INFINITY; if (tid < own) { g = 0.f; for (int d = 0; d < 64; ++d) g += bf2f(QKV[(rb + t) * kNQKV + qcol + d]) * bf2f(KMEAN[(((size_t)b * 32 + tid) * 4 + h) * 64 + d]); } red[tid] = g; }
    __syncthreads();
    allowed = 0;
    for (int round = 0; round < 3; ++round) { float best = -INFINITY; int bi = -1; for (int n = 0; n < own; ++n) if (!((allowed >> n) & 1u) && red[n] > best) { best = red[n]; bi = n; } if (bi >= 0) allowed |= 1u << bi; }
    allowed |= 1u << own;
    __syncthreads();
  }
  const int n = (mode == M_DIL) ? 387 : (t + 1);
  float lmax = -INFINITY;
  for (int e = tid; e < n; e += 256) {
    int j = e; bool ok = true; float bias = 0.f;
    if (mode == M_DIL) { const int pi = e / 129, i = e % 129; const int r = (pi == 0) ? 1 : (pi == 1 ? 4 : 16); j = t - i * r; ok = (j >= 0); }
    float sv = -INFINITY;
    if (ok) {
      if (mode == M_FOX) bias = -((const float*)(ws + OFF_CB))[(size_t)(b * 4 + h) * kT + j];
      if (mode == M_DSA) { const u64 w = ((const u64*)(ws + OFF_MASK))[((size_t)(b * 256 + (t >> 5)) * 128 + (j >> 6)) * 32 + (t & 31)]; const int kk = j & 63; ok = (w >> (16 * (kk & 3) + (kk >> 2))) & 1ull; }
      if (mode == M_MOBA) ok = (allowed >> (j >> 8)) & 1u;
      if (ok) { float d_ = 0.f; for (int d = 0; d < 64; ++d) d_ += bf2f(QKV[(rb + t) * kNQKV + qcol + d]) * bf2f(QKV[(rb + j) * kNQKV + kcol + d]); sv = d_ + bias; }
    }
    sc[e] = sv; lmax = fmaxf(lmax, sv);
  }
  __syncthreads();
  const float m = blk_max(lmax, red);
  const int d = tid & 63, part = tid >> 6;
  float acc = 0.f, l = 0.f;
  for (int e = part; e < n; e += 4) {
    const float sv = sc[e];
    if (sv > -INFINITY) {
      int j = e; if (mode == M_DIL) { const int pi = e / 129, i = e % 129; const int r = (pi == 0) ? 1 : (pi == 1 ? 4 : 16); j = t - i * r; }
      const float pe = exp2f(sv - m); acc += pe * bf2f(QKV[(rb + j) * kNQKV + vcol + d]); l += pe;
    }
  }
  acc4[tid] = acc; if (d == 0) l4[part] = l;
  __syncthreads();
  if (tid < 64) {
    const float o = (acc4[tid] + acc4[tid + 64] + acc4[tid + 128] + acc4[tid + 192]) / (l4[0] + l4[1] + l4[2] + l4[3]);
    const float got = bf2f(O[(rb + t) * kD + mode * 256 + h * 64 + tid]);
    if (!(fabsf(got - o) <= 0.003f + 0.012f * fabsf(o))) sc_flag(p, mode);
  }
  __syncthreads();
}
DI void check_select(const Params& p, const int b, const int t, char* lds) {
  const int tid = tidx(); char* ws = wsp(p);
  float* sc = (float*)lds; unsigned* cnts = (unsigned*)(lds + 32768);
  const u16* IDXQ = (const u16*)(ws + OFF_IDXQ); const u16* IDXK = (const u16*)(ws + OFF_IDXK); const float* WI = (const float*)(ws + OFF_WI);
  const size_t rb = (size_t)b * kT;
  if (tid < 2) cnts[tid] = 0;
  for (int j = tid; j <= t; j += 256) {
    float tot = 0.f;
    for (int hh = 0; hh < 8; ++hh) { float d_ = 0.f; for (int e = 0; e < 32; ++e) d_ += bf2f(IDXQ[(rb + t) * 256 + hh * 32 + e]) * bf2f(IDXK[(rb + j) * 32 + e]); tot += WI[(rb + t) * 8 + hh] * fmaxf(d_, 0.f); }
    sc[j] = tot + 0.0f;
  }
  __syncthreads();
  const int jend = (t | 127);
  unsigned mism = 0, total = 0;
  for (int j = tid; j <= jend; j += 256) {
    bool sel = false;
    if (j <= t) { const float sj = sc[j]; int rank = 0; for (int i = 0; i <= t; ++i) { const float si = sc[i]; rank += (si > sj || (si == sj && i < j)) ? 1 : 0; } sel = rank < 256; }
    const u64 w = ((const u64*)(ws + OFF_MASK))[((size_t)(b * 256 + (t >> 5)) * 128 + (j >> 6)) * 32 + (t & 31)]; const int kk = j & 63;
    const bool got = (w >> (16 * (kk & 3) + (kk >> 2))) & 1ull;
    if (got) ++total; if (got != sel) ++mism; if (got && j > t) mism += 100;
  }
  atomicAdd(&cnts[0], mism); atomicAdd(&cnts[1], total);
  __syncthreads();
  if (tid == 0) { const unsigned want = (t + 1 < 256) ? (unsigned)(t + 1) : 256u; if (cnts[1] != want) sc_flag(p, 8); if (cnts[1] > want) sc_flag(p, 9); if (cnts[1] < want) sc_flag(p, 10); if (cnts[1] > want + 8) sc_flag(p, 11); if (cnts[1] + 8 < want) sc_flag(p, 12); if (cnts[1] > want + 64) sc_flag(p, 13); if (cnts[1] + 64 < want) sc_flag(p, 14); if (cnts[0] > 4) sc_flag(p, 4); if (cnts[0] > 12) sc_flag(p, 5); if (cnts[0] > 40) sc_flag(p, 6); if (cnts[0] > 200) sc_flag(p, 7); }
  __syncthreads();
}
DI void check_inproj(const Params& p, const int m, char* lds) {
  const int tid = tidx(); char* ws = wsp(p);
  float* raw = (float*)lds; float* xs = (float*)(lds + 16384);
  for (int k = tid; k < kD; k += 256) xs[k] = p.x[(size_t)m * kD + k];
  __syncthreads();
  for (int c = tid; c < kDIN; c += 256) { float a = 0.f; for (int k = 0; k < kD; ++k) a += xs[k] * p.w_in[(size_t)k * kDIN + c]; raw[c] = a; }
  __syncthreads();
  const int t = m & (kT - 1);
  const u16* QKV = (const u16*)(ws + OFF_QKV);
  bool bad = false;
  for (int c = tid; c < kDIN; c += 256) {
    float expect, got;
    int kind, off, mybase;
    bool scale = false;
    if (c < 256) { kind = 0; off = c; mybase = 0; scale = true; }
    else if (c < 768) { kind = 0; off = c - 256; mybase = 256; }
    else if (c < 772) { kind = 2; off = c - 768; mybase = 0; }
    else if (c < 1028) { kind = 1; off = c - 772; mybase = 768; scale = true; }
    else if (c < 1284) { kind = 1; off = c - 1028; mybase = 1024; }
    else if (c < 1540) { kind = 0; off = c - 1284; mybase = 1280; }
    else if (c < 1796) { kind = 3; off = c - 1540; mybase = 0; }
    else if (c < 1828) { kind = 4; off = c - 1796; mybase = 0; }
    else if (c < 1836) { kind = 5; off = c - 1828; mybase = 0; }
    else if (c < 2092) { kind = 1; off = c - 1836; mybase = 1536; scale = true; }
    else if (c < 2348) { kind = 1; off = c - 2092; mybase = 1792; }
    else if (c < 2604) { kind = 0; off = c - 2348; mybase = 2048; }
    else if (c < 2860) { kind = 1; off = c - 2604; mybase = 2304; scale = true; }
    else if (c < 3116) { kind = 1; off = c - 2860; mybase = 2560; }
    else { kind = 0; off = c - 3116; mybase = 2816; }
    if (kind == 0) { expect = raw[c]; if (scale) expect *= kQScale; got = bf2f(QKV[(size_t)m * kNQKV + mybase + off]); }
    else if (kind == 1) {
      const int dh = off & 63, i = dh & 31; const int cb_ = c - dh; const float x1 = raw[cb_ + i], x2 = raw[cb_ + i + 32];
      const float ang = (float)t * powf(10000.0f, -(float)i / 32.0f); const float cs = cosf(ang), sn = sinf(ang);
      expect = (dh < 32) ? (x1 * cs - x2 * sn) : (x2 * cs + x1 * sn); if (scale) expect *= kQScale;
      got = bf2f(QKV[(size_t)m * kNQKV + mybase + off]);
    } else if (kind == 2) { const float z = raw[c] + p.b_f[off]; expect = -logf(1.0f + expf(-z)); got = ((const float*)(ws + OFF_LOGF))[(size_t)m * 4 + off]; }
    else if (kind == 3 || kind == 4) {
      const int dh = off & 31, i = dh & 15; const int cb_ = c - dh; const float x1 = raw[cb_ + i], x2 = raw[cb_ + i + 16];
      const float ang = (float)t * powf(10000.0f, -(float)i / 16.0f); const float cs = cosf(ang), sn = sinf(ang);
      expect = (dh < 16) ? (x1 * cs - x2 * sn) : (x2 * cs + x1 * sn);
      got = (kind == 3) ? bf2f(((const u16*)(ws + OFF_IDXQ))[(size_t)m * 256 + off]) : bf2f(((const u16*)(ws + OFF_IDXK))[(size_t)m * 32 + off]);
    } else { expect = raw[c]; got = ((const float*)(ws + OFF_WI))[(size_t)m * 8 + off]; }
    if (!(fabsf(got - expect) <= 0.03f + 0.02f * fabsf(expect))) bad = true;
  }
  if (bad) sc_flag(p, 7);
  __syncthreads();
}
DI void check_misc(const Params& p, const int idx) {
  const int tid = tidx(); char* ws = wsp(p);
  if (idx < 16) {
    if (tid == 0) {
      const float* LOGF = (const float*)(ws + OFF_LOGF); const float* CB = (const float*)(ws + OFF_CB);
      double run = 0.0; bool bad = false;
      for (int t = 0; t < kT; ++t) { run += (double)LOGF[((size_t)(idx >> 2) * kT + t) * 4 + (idx & 3)]; if ((t & 1023) == 1023 || t == 0 || t == 77) { const double want = run * 1.4426950408889634; if (!(fabs((double)CB[(size_t)idx * kT + t] - want) <= 1e-3 + 1e-4 * fabs(want))) bad = true; } }
      if (bad) sc_flag(p, 6);
    }
  } else {
    const int k = idx - 16; const int b = k >> 5, blk = k & 31;
    const u16* QKV = (const u16*)(ws + OFF_QKV); const u16* KMEAN = (const u16*)(ws + OFF_KMEAN);
    float s_ = 0.f; for (int i = 0; i < 256; ++i) s_ += bf2f(QKV[((size_t)b * kT + blk * 256 + i) * kNQKV + 2560 + tid]);
    const float want = s_ / 256.0f; const float got = bf2f(KMEAN[(((size_t)b * 32 + blk) * 4 + (tid >> 6)) * 64 + (tid & 63)]);
    if (!(fabsf(got - want) <= 0.005f + 0.01f * fabsf(want))) sc_flag(p, 5);
  }
}
DI unsigned sc_rng(unsigned x) { x ^= x >> 16; x *= 0x7feb352du; x ^= x >> 15; x *= 0x846ca68bu; x ^= x >> 16; return x; }
DI void selfcheck_phase(const Params& p, char* lds) {
  for (int i = blockIdx.x; i < 848; i += gridDim.x) {
    const unsigned r = sc_rng(i * 2654435761u + 12345u);
    if (i < 512) {
      const int mode = i >> 7, k = i & 127; int t;
      if (k < 8) t = k; else if (k < 16) t = 248 + k; else if (k < 24) t = 8184 + (k - 16); else if (k < 40) t = ((k - 24) * 512 + 255 + (k & 1)) & 8191; else t = r & 8191;
      check_attn(p, mode, (r >> 13) & 3, t, (r >> 15) & 3, lds);
    } else if (i < 640) {
      const int k = i - 512; int t;
      if (k < 8) t = 250 + k; else if (k < 16) t = 8184 + (k - 8); else if (k < 20) t = k - 16; else t = r & 8191;
      check_select(p, (r >> 13) & 3, t, lds);
    } else if (i < 704) {
      const int k = i - 640; const int m = (k < 4) ? k : (k < 8 ? kM - 1 - (k - 4) : (int)(r & (kM - 1)));
      check_inproj(p, m, lds);
    } else check_misc(p, i - 704);
  }
}
#endif

#define XB_TMO      128
#define XB_XCNT(j)  (256  + 64 * (j))
#define XB_XSUB(j)  (1280 + 64 * (j))
#define XB_XGEN(j)  (2304 + 64 * (j))
#define XB_TOP      3328
#define XB_TOPGEN   3392
#define XCD_BAR_WORDS 3456
#define XB_SPIN_CAP (1u << 22)
#define LAS __attribute__((address_space(3)))
DI unsigned xb_ld(unsigned* p) { return __hip_atomic_load(p, __ATOMIC_RELAXED, __HIP_MEMORY_SCOPE_AGENT); }
DI unsigned xb_add(unsigned* p, unsigned v) { return __hip_atomic_fetch_add(p, v, __ATOMIC_RELAXED, __HIP_MEMORY_SCOPE_AGENT); }
DI unsigned xb_xcc_id() { return (unsigned)__builtin_amdgcn_s_getreg((3 << 11) | 20) & 0xFu; }
#define XB_SPIN(cond, bar) do { unsigned _sp = 0; while (cond) { __builtin_amdgcn_s_sleep(1); \
    if ((++_sp & 255u) == 0u) { if (xb_ld(&(bar)[XB_TMO])) break; if (_sp > XB_SPIN_CAP) { atomicAdd(&(bar)[XB_TMO], 1u); break; } } } } while (0)
struct XcdBarrier { unsigned* bar; unsigned x; volatile LAS unsigned* st; };
DI XcdBarrier xcd_barrier_post(unsigned* bar, volatile LAS unsigned* st) {
  XcdBarrier b; b.bar = bar; b.x = xb_xcc_id(); b.st = st;
  if (threadIdx.x == 0) (void)xb_add(&bar[XB_XCNT(b.x)], 1u);
  return b;
}
DI void xcd_barrier_complete(unsigned* bar, unsigned x, unsigned& nloc, unsigned& nx) {
  const unsigned G = gridDim.x * gridDim.y * gridDim.z;
  unsigned sum, cnt, mine, sp = 0u;
  for (;;) {
    sum = 0u; cnt = 0u; mine = 0u;
#pragma unroll
    for (unsigned j = 0; j < 16; ++j) { const unsigned c = xb_ld(&bar[XB_XCNT(j)]); sum += c; cnt += (c > 0u) ? 1u : 0u; mine = (j == x) ? c : mine; }
    if (sum == G) break;
    __builtin_amdgcn_s_sleep(1);
    if ((++sp & 255u) == 0u) { if (xb_ld(&bar[XB_TMO])) break; if (sp > XB_SPIN_CAP) { atomicAdd(&bar[XB_TMO], 1u); break; } }
  }
  nloc = mine > 0u ? mine : 1u; nx = cnt > 0u ? cnt : 1u;
}
DI void xcd_barrier(const XcdBarrier& b) {
  asm volatile("s_waitcnt vmcnt(0)" ::: "memory");
  __syncthreads();
  if (threadIdx.x == 0) {
    unsigned* bar = b.bar;
    __builtin_amdgcn_s_waitcnt(0);
    unsigned nloc = b.st[0], nx = b.st[1];
    if (nloc == 0u) { xcd_barrier_complete(bar, b.x, nloc, nx); b.st[0] = nloc; b.st[1] = nx; }
    const unsigned old = xb_add(&bar[XB_XSUB(b.x)], 1u);
    const unsigned gen = old / nloc;
    if (old + 1u == (gen + 1u) * nloc) {
      __builtin_amdgcn_fence(__ATOMIC_RELEASE, "agent");
      asm volatile("s_waitcnt vmcnt(0)" ::: "memory");
      const unsigned og = xb_add(&bar[XB_TOP], 1u);
      const unsigned tg = og / nx;
      if (og + 1u == (tg + 1u) * nx) xb_add(&bar[XB_TOPGEN], 1u);
      else XB_SPIN(xb_ld(&bar[XB_TOPGEN]) == tg, bar);
      __builtin_amdgcn_fence(__ATOMIC_ACQUIRE, "agent");
      xb_add(&bar[XB_XGEN(b.x)], 1u);
      asm volatile("s_waitcnt vmcnt(0)" ::: "memory");
    } else {
      XB_SPIN(xb_ld(&bar[XB_XGEN(b.x)]) == gen, bar);
      __builtin_amdgcn_fence(__ATOMIC_ACQUIRE, "agent");
      asm volatile("s_waitcnt vmcnt(0)" ::: "memory");
    }
  }
  __syncthreads();
}
DI int next_item(unsigned* cnt, int* slot) {
  __syncthreads();
  if (threadIdx.x == 0) *slot = (int)atomicAdd(cnt, 1u);
  __syncthreads();
  return __builtin_amdgcn_readfirstlane(*slot);
}

__global__ void __launch_bounds__(256, 2) mega(Params p_in) {
  extern __shared__ __attribute__((aligned(16))) char lds[];
  int* slot = (int*)(lds + 65536 + 10240);
  volatile LAS unsigned* xst = (volatile LAS unsigned*)(LAS char*)(lds + 65536 + 10240 + 16);
  XcdBarrier xbar;
  const unsigned xcc = xb_xcc_id() & 7u;
  if (p_in.coop) {
    if (threadIdx.x == 0) { xst[0] = 0u; xst[1] = 0u; xst[2] = 0u; xst[3] = 0u; }
    __syncthreads();
    xbar = xcd_barrier_post((unsigned*)(p_in.ws + OFF_BAR), xst);
  }
  char* ws; unsigned* cnt;
  const Params& p = p_in;
  for (int ph = p_in.phase_begin; ph < p_in.phase_end; ++ph) {
    { size_t z = 0; asm volatile("" : "+s"(z)); ws = p_in.ws + z; }
    cnt = (unsigned*)(ws + OFF_CNT);
    for (int rep = 0; rep < 2; ++rep) {
    if (rep == 1) { if (ph == 0 || !((REPEAT_MASK >> ((ph - 1) & 7)) & 1)) break; if (p_in.coop) xcd_barrier(xbar); cnt += 1024; }
    if (ph == 0) {
      if (HAS(8)) init_phase(p, lds);
    } else {
      const int l = (ph - 1) >> 3, s = (ph - 1) & 7;
      if (HAS(0) && s == 0) {
        gemm_phase<EPI_INPROJ>(p, (const u16*)(ws + OFF_WIN) + (size_t)l * kNPAD * kD, (const u16*)(ws + OFF_XB), kNPAD, kD, l, lds, cnt + 256 + ph * 8, slot, xcc);
      } else if (HAS(1) && s == 1) {
        unsigned* c = cnt + l;
        constexpr int nitems = 16 + 128 + kM / 4;
        for (int i = next_item(c, slot); i < nitems; i = next_item(c, slot)) {
          if (i < 16) cumsum_item(p, i, lds);
          else if (i < 144) kmean_item(p, i - 16);
          else { const int k = i - 144; select_item(p, k & 3, 4 * (2047 - (k >> 2)), lds); }
        }
      } else if (HAS(2) && s == 2) {
        for (int pass = 0; pass < 2; ++pass) {
#pragma unroll 1
          for (int mode = 0; mode < 4; ++mode) {
            XQ q; q.c = cnt + 600 + (l * 4 + mode) * 8; q.step = pass; q.xcc = xcc;
            const int max_step = pass ? 8 : 1;
            for (int v = xq_pull(q, 128, slot, max_step); v >= 0; v = xq_pull(q, 128, slot, max_step)) {
              const int xq = v >> 7, tk = v & 127; const int bh = 2 * xq + (tk & 1), j = tk >> 1;
              if (mode == 0) attn_item<M_FOX>(p, bh >> 2, bh & 3, 63 - j, lds);
              else if (mode == 1) attn_item<M_DSA>(p, bh >> 2, bh & 3, 63 - j, lds);
              else if (mode == 2) attn_item<M_MOBA>(p, bh >> 2, bh & 3, 63 - j, lds);
              else attn_item<M_DIL>(p, bh >> 2, bh & 3, j, lds);
            }
          }
        }
      } else if (HAS(3) && s == 3) {
        gemm_phase<EPI_RESID>(p, (const u16*)(ws + OFF_WO) + (size_t)l * kD * kD, (const u16*)(ws + OFF_O), kD, kD, l, lds, cnt + 256 + ph * 8, slot, xcc);
      } else if (HAS(4) && s == 4) {
        ln_phase(p, p.ln1_g + l * kD, p.ln1_b + l * kD, false);
      } else if (HAS(5) && s == 5) {
        gemm_phase<EPI_RELU2>(p, (const u16*)(ws + OFF_WUP) + (size_t)l * kDFF * kD, (const u16*)(ws + OFF_XB), kDFF, kD, l, lds, cnt + 256 + ph * 8, slot, xcc);
      } else if (HAS(6) && s == 6) {
        gemm_phase<EPI_RESID>(p, (const u16*)(ws + OFF_WDN) + (size_t)l * kD * kDFF, (const u16*)(ws + OFF_QKV), kD, kDFF, l, lds, cnt + 256 + ph * 8, slot, xcc);
      } else if (HAS(7)) {
        ln_phase(p, p.ln2_g + l * kD, p.ln2_b + l * kD, l == kDepth - 1);
      }
    }
    }
    if (p_in.coop && ph + 1 < p_in.phase_end) { if (p_in.pad == 0x5eed) cg::this_grid().sync(); else xcd_barrier(xbar); }
  }
}

#if SELFCHECK
__global__ void __launch_bounds__(256) selfcheck_kernel(Params p) {
  extern __shared__ __attribute__((aligned(16))) char lds[];
  selfcheck_phase(p, lds);
}
__global__ void poison_kernel(Params p) {
  if (blockIdx.x == 0 && threadIdx.x == 0) {
    const unsigned f = ((volatile unsigned*)(p.ws + OFF_CNT))[200];
    if (f) { const int top = 31 - __clz((int)f); p.out[0] = 1024.0f * (float)(1 << top); p.out[1] = (float)f; }
  }
}
#endif

extern "C" void kernel_launch(void* const* d_in, const int* in_sizes, int n_in, void* d_out, int out_size, void* d_ws, size_t ws_size, hipStream_t stream) {
  (void)in_sizes; (void)n_in; (void)out_size;
  if (ws_size < WS_TOTAL) { fprintf(stderr, "workspace too small: %zu < %zu\n", ws_size, (size_t)WS_TOTAL); return; }
  Params p{};
  p.x = (const float*)d_in[0]; p.w_in = (const float*)d_in[1]; p.b_f = (const float*)d_in[2]; p.w_o = (const float*)d_in[3];
  p.ln1_g = (const float*)d_in[4]; p.ln1_b = (const float*)d_in[5]; p.w_up = (const float*)d_in[6]; p.w_down = (const float*)d_in[7];
  p.ln2_g = (const float*)d_in[8]; p.ln2_b = (const float*)d_in[9];
  p.out = (float*)d_out; p.ws = (char*)d_ws; p.pad = 0;
  static int grid_blocks = 0;
  if (!grid_blocks) {
    hipFuncSetAttribute((const void*)mega, hipFuncAttributeMaxDynamicSharedMemorySize, LDS_BYTES);
    int dev = 0, cus = 0, per_cu = 0;
    hipGetDevice(&dev);
    hipDeviceGetAttribute(&cus, hipDeviceAttributeMultiprocessorCount, dev);
    hipOccupancyMaxActiveBlocksPerMultiprocessor(&per_cu, (const void*)mega, 256, LDS_BYTES);
    if (per_cu > 2) per_cu = 2;
    if (per_cu < 1) per_cu = 1;
    grid_blocks = cus * per_cu;
  }
  (void)hipMemsetAsync((char*)d_ws + OFF_CNT, 0, SZ_CNT + SZ_BAR, stream);
  constexpr int nphases = 1 + 8 * kDepth;
#if SELFCHECK
  {
    hipFuncSetAttribute((const void*)selfcheck_kernel, hipFuncAttributeMaxDynamicSharedMemorySize, LDS_BYTES);
    Params pa = p; pa.phase_begin = 0; pa.phase_end = 4; pa.coop = 1;
    void* a1[] = {&pa};
    hipLaunchCooperativeKernel((const void*)mega, dim3(grid_blocks), dim3(256), a1, LDS_BYTES, stream);
    hipLaunchKernelGGL(selfcheck_kernel, dim3(grid_blocks), dim3(256), LDS_BYTES, stream, p);
    hipMemsetAsync((char*)d_ws + OFF_BAR, 0, SZ_BAR, stream);
    Params pb = p; pb.phase_begin = 4; pb.phase_end = nphases; pb.coop = 1;
    void* a2[] = {&pb};
    hipLaunchCooperativeKernel((const void*)mega, dim3(grid_blocks), dim3(256), a2, LDS_BYTES, stream);
    hipLaunchKernelGGL(poison_kernel, dim3(1), dim3(64), 0, stream, p);
  }
#elif ONE_LAUNCH
  p.phase_begin = 0; p.phase_end = nphases; p.coop = 1;
  void* args[] = {&p};
  hipError_t e = hipLaunchCooperativeKernel((const void*)mega, dim3(grid_blocks), dim3(256), args, LDS_BYTES, stream);
  if (e != hipSuccess) fprintf(stderr, "cooperative launch failed: %s (grid %d)\n", hipGetErrorString(e), grid_blocks);
#else
  for (int ph = 0; ph < nphases; ++ph) {
    p.phase_begin = ph; p.phase_end = ph + 1; p.coop = 0;
    hipLaunchKernelGGL(mega, dim3(grid_blocks), dim3(256), LDS_BYTES, stream, p);
  }
#endif
}
```
